# Optimizing an MI355X kernel written in HIP

```python
import jax, jax.numpy as jnp
from jax import lax
import numpy as np

D_MODEL = 2048
BATCH = 16
SEQ = 2048
DEPTH = 4

MIX_HALF = D_MODEL // 2
RET_HEADS = 4
RET_HEAD_DIM = MIX_HALF // RET_HEADS
RET_CHUNK = 128
RET_THETA = 10000.0
SGU_GROUPS = 4
SGU_GROUP_DIM = MIX_HALF // SGU_GROUPS
SGU_CHUNK = 128
POOL_WINDOWS = (2, 4, 8, 16)
POOL_GROUP_DIM = MIX_HALF // len(POOL_WINDOWS)
MOBA_HEADS = 8
MOBA_HEAD_DIM = MIX_HALF // MOBA_HEADS
MOBA_BLOCK = 256
MOBA_TOPK = 3
MOBA_QUERY_CHUNK = 4
ROPE_THETA = 500000.0
ROT_DIM = MOBA_HEAD_DIM // 4
D_FF = 5632
PLE_DIM = 256
N_NORMS = 8
N_EVEN = (DEPTH + 1) // 2
N_ODD = DEPTH // 2
EPS = 1e-6
NEG = -1e30

kernel_name = "hybrid_retention_sgu_pool_moba_macaron"


def rms_norm(x, gain=None):
    xf = x.astype(jnp.float32)
    y = xf * lax.rsqrt(jnp.mean(xf * xf, axis=-1, keepdims=True) + EPS)
    if gain is not None:
        y = y * gain.astype(jnp.float32)
    return y.astype(x.dtype)


def rotary(x, rot_dim, theta):
    s = x.shape[1]
    half = rot_dim // 2
    inv = 1.0 / jnp.power(jnp.float32(theta), jnp.arange(half, dtype=jnp.float32) / half)
    ang = jnp.arange(s, dtype=jnp.float32)[:, None] * inv[None, :]
    cos = jnp.cos(ang)[None, :, None, :]
    sin = jnp.sin(ang)[None, :, None, :]
    xf = x.astype(jnp.float32)
    x1 = xf[..., :half]
    x2 = xf[..., half:rot_dim]
    out = jnp.concatenate([x1 * cos - x2 * sin, x2 * cos + x1 * sin, xf[..., rot_dim:]], axis=-1)
    return out.astype(x.dtype)


def swiglu(h, wg, wu, wd):
    return (jax.nn.silu(h @ wg) * (h @ wu)) @ wd


def retention(q, k, v, g):
    b, s, _ = q.shape
    h, d, c = RET_HEADS, RET_HEAD_DIM, RET_CHUNK
    nc = s // c
    q = rotary(q.reshape(b, s, h, d), d, RET_THETA)
    k = rotary(k.reshape(b, s, h, d), d, RET_THETA) * (d ** -0.5)
    v = v.reshape(b, s, h, d)
    to_chunks = lambda t: t.astype(jnp.float32).reshape(b, nc, c, h, d).transpose(1, 0, 3, 2, 4)
    log_gamma = jnp.log(1.0 - jnp.power(2.0, -5.0 - jnp.arange(h, dtype=jnp.float32)))
    pos = jnp.arange(c, dtype=jnp.float32)
    rel = pos[:, None] - pos[None, :]
    intra_decay = jnp.exp(jnp.maximum(rel, 0.0)[None] * log_gamma[:, None, None]) * (rel >= 0)[None]
    q_decay = jnp.exp((pos + 1.0)[None, :] * log_gamma[:, None])[..., None]
    k_decay = jnp.exp((c - 1.0 - pos)[None, :] * log_gamma[:, None])[..., None]
    chunk_decay = jnp.exp(c * log_gamma)[:, None, None]

    def step(state, qkv):
        qc, kc, vc = qkv
        scores = jnp.einsum('bhtd,bhsd->bhts', qc, kc) * intra_decay
        out = jnp.einsum('bhts,bhse->bhte', scores, vc) + jnp.einsum('bhtd,bhde->bhte', qc * q_decay, state)
        state = state * chunk_decay + jnp.einsum('bhsd,bhse->bhde', kc * k_decay, vc)
        return state, out

    state0 = jnp.zeros((b, h, d, d), jnp.float32)
    _, o = lax.scan(step, state0, (to_chunks(q), to_chunks(k), to_chunks(v)))
    o = rms_norm(o.transpose(1, 0, 3, 2, 4).reshape(b, s, h, d))
    return (o.reshape(b, s, h * d) * jax.nn.silu(g.astype(jnp.float32))).astype(g.dtype)


def spatial_gating(u, v, w_s, b_s, v_gain):
    b, s, _ = u.shape
    gr, dg, c = SGU_GROUPS, SGU_GROUP_DIM, SGU_CHUNK
    nc = s // c
    u = jax.nn.gelu(u)
    v = rms_norm(jax.nn.gelu(v).reshape(b, s, gr, dg), v_gain.reshape(gr, dg))
    w = w_s * jnp.tril(jnp.ones((c, c), w_s.dtype))[None]
    sv = jnp.einsum('gts,bcsgd->bctgd', w, v.reshape(b, nc, c, gr, dg)) + b_s.T[None, None, :, :, None]
    return (u.reshape(b, nc, c, gr, dg) * sv).reshape(b, s, gr * dg)


def pool_mixer(z, w_pool, scale):
    b, s, _ = z.shape
    zf = z.astype(jnp.float32).reshape(b, s, len(POOL_WINDOWS), POOL_GROUP_DIM)
    cs = jnp.cumsum(zf, axis=1)
    t = jnp.arange(s)
    outs = []
    for gi, w in enumerate(POOL_WINDOWS):
        c = cs[:, :, gi]
        prev = jnp.pad(c, ((0, 0), (w, 0), (0, 0)))[:, :s]
        cnt = jnp.minimum(t + 1, w).astype(jnp.float32)
        outs.append((c - prev) / cnt[None, :, None] - zf[:, :, gi])
    y = jnp.stack(outs, axis=2).astype(z.dtype)
    y = jnp.einsum('bsgc,gcd->bsgd', y, w_pool).reshape(b, s, -1)
    return y * scale


def moba(q, k, v):
    b, s, _ = q.shape
    h, hd, bs, qc_len = MOBA_HEADS, MOBA_HEAD_DIM, MOBA_BLOCK, MOBA_QUERY_CHUNK
    nb = -(-s // bs)
    s_pad = nb * bs
    nq = s // qc_len
    n_sel = min(MOBA_TOPK, nb)
    q = rotary(q.reshape(b, s, h, hd), ROT_DIM, ROPE_THETA).transpose(0, 2, 1, 3)
    k = rotary(k.reshape(b, s, h, hd), ROT_DIM, ROPE_THETA).transpose(0, 2, 1, 3)
    v = v.reshape(b, s, h, hd).transpose(0, 2, 1, 3)
    pad = ((0, 0), (0, 0), (0, s_pad - s), (0, 0))
    kb = jnp.pad(k, pad).reshape(b, h, nb, bs, hd)
    vb = jnp.pad(v, pad).reshape(b, h, nb, bs, hd)
    k_mean = jnp.mean(kb.astype(jnp.float32), axis=3)
    t = jnp.arange(s)
    q_block = t // bs
    past = jnp.arange(nb)[None, :] < q_block[:, None]
    gate = jnp.einsum('bhsd,bhnd->bhsn', q.astype(jnp.float32), k_mean)
    gate = jnp.where(past, gate, NEG)
    _, top = lax.top_k(gate, n_sel)
    own = jnp.broadcast_to(q_block.astype(top.dtype)[None, None, :, None], (b, h, s, 1))
    idx = jnp.concatenate([top, own], axis=-1)
    slot_ok = jnp.arange(n_sel)[None, :] < q_block[:, None]
    causal = jnp.arange(bs)[None, :] <= (t % bs)[:, None]
    mask = jnp.concatenate([jnp.broadcast_to(slot_ok[:, :, None], (s, n_sel, bs)), causal[:, None, :]], axis=1)
    qcs = q.reshape(b, h, nq, qc_len, hd).transpose(2, 0, 1, 3, 4)
    ics = idx.reshape(b, h, nq, qc_len, n_sel + 1).transpose(2, 0, 1, 3, 4)
    mcs = mask.reshape(nq, qc_len, n_sel + 1, bs)
    gather_blocks = jax.vmap(jax.vmap(lambda blocks, ids: blocks[ids]))
    scale = hd ** -0.5

    def attend(args):
        qc, ic, mc = args
        kg = gather_blocks(kb, ic)
        vg = gather_blocks(vb, ic)
        logits = jnp.einsum('bhqd,bhqnkd->bhqnk', qc, kg).astype(jnp.float32) * scale
        logits = jnp.where(mc, logits, NEG)
        pr = jax.nn.softmax(logits.reshape(b, h, qc_len, -1), axis=-1).astype(vg.dtype)
        return jnp.einsum('bhqk,bhqkd->bhqd', pr, vg.reshape(b, h, qc_len, -1, hd))

    o = lax.map(attend, (qcs, ics, mcs))
    return o.transpose(1, 0, 3, 2, 4).reshape(b, s, h * hd)


def even_mixer(h, w_in, w_out, sgu_w, sgu_b, sgu_gain):
    z = h @ w_in
    q, k, v, g, u, vs = jnp.split(z, 6, axis=-1)
    y = jnp.concatenate([retention(q, k, v, g), spatial_gating(u, vs, sgu_w, sgu_b, sgu_gain)], axis=-1)
    return y @ w_out


def odd_mixer(h, w_in, w_out, pool_w, pool_scale):
    z = h @ w_in
    pz, q, k, v = jnp.split(z, 4, axis=-1)
    y = jnp.concatenate([pool_mixer(pz, pool_w, pool_scale), moba(q, k, v)], axis=-1)
    return y @ w_out


def setup_inputs(seed: int = 0) -> dict:
    key = jax.random.key(seed)
    ks = jax.random.split(key, 17)
    nrm = jax.random.normal
    f32 = jnp.float32
    return {
        "x": nrm(ks[0], (BATCH, SEQ, D_MODEL), f32),
        "p": nrm(ks[1], (DEPTH, BATCH, SEQ, PLE_DIM), f32),
        "norm_gains": 1.0 + 0.1 * nrm(ks[2], (DEPTH, N_NORMS, D_MODEL), f32),
        "w_ffn_gate": nrm(ks[3], (DEPTH, 2, D_MODEL, D_FF), f32) * D_MODEL ** -0.5,
        "w_ffn_up": nrm(ks[4], (DEPTH, 2, D_MODEL, D_FF), f32) * D_MODEL ** -0.5,
        "w_ffn_down": nrm(ks[5], (DEPTH, 2, D_FF, D_MODEL), f32) * D_FF ** -0.5,
        "w_in_even": nrm(ks[6], (N_EVEN, D_MODEL, 6 * MIX_HALF), f32) * D_MODEL ** -0.5,
        "w_out_even": nrm(ks[7], (N_EVEN, 2 * MIX_HALF, D_MODEL), f32) * (2 * MIX_HALF) ** -0.5,
        "sgu_w": nrm(ks[8], (N_EVEN, SGU_GROUPS, SGU_CHUNK, SGU_CHUNK), f32) * SGU_CHUNK ** -0.5,
        "sgu_b": 1.0 + 0.1 * nrm(ks[9], (N_EVEN, SGU_GROUPS, SGU_CHUNK), f32),
        "sgu_gain": 1.0 + 0.1 * nrm(ks[10], (N_EVEN, MIX_HALF), f32),
        "w_in_odd": nrm(ks[11], (N_ODD, D_MODEL, 4 * MIX_HALF), f32) * D_MODEL ** -0.5,
        "w_out_odd": nrm(ks[12], (N_ODD, 2 * MIX_HALF, D_MODEL), f32) * (2 * MIX_HALF) ** -0.5,
        "pool_w": nrm(ks[13], (N_ODD, len(POOL_WINDOWS), POOL_GROUP_DIM, POOL_GROUP_DIM), f32) * POOL_GROUP_DIM ** -0.5,
        "pool_scale": 1.0 + 0.1 * nrm(ks[14], (N_ODD, MIX_HALF), f32),
        "w_ple_gate": nrm(ks[15], (DEPTH, D_MODEL, D_MODEL), f32) * D_MODEL ** -0.5,
        "w_ple_proj": nrm(ks[16], (DEPTH, PLE_DIM, D_MODEL), f32) * PLE_DIM ** -0.5,
    }


def reference(x, p, norm_gains, w_ffn_gate, w_ffn_up, w_ffn_down, w_in_even, w_out_even, sgu_w, sgu_b,
              sgu_gain, w_in_odd, w_out_odd, pool_w, pool_scale, w_ple_gate, w_ple_proj):
    for i in range(DEPTH):
        ng = norm_gains[i]
        h = rms_norm(x, ng[0])
        x = x + 0.5 * rms_norm(swiglu(h, w_ffn_gate[i, 0], w_ffn_up[i, 0], w_ffn_down[i, 0]), ng[1])
        h = rms_norm(x, ng[2])
        if i % 2 == 0:
            j = i // 2
            m = even_mixer(h, w_in_even[j], w_out_even[j], sgu_w[j], sgu_b[j], sgu_gain[j])
        else:
            j = i // 2
            m = odd_mixer(h, w_in_odd[j], w_out_odd[j], pool_w[j], pool_scale[j])
        x = x + rms_norm(m, ng[3])
        h = rms_norm(x, ng[4])
        x = x + 0.5 * rms_norm(swiglu(h, w_ffn_gate[i, 1], w_ffn_up[i, 1], w_ffn_down[i, 1]), ng[5])
        gate = jax.nn.sigmoid(rms_norm(x, ng[6]) @ w_ple_gate[i])
        x = x + rms_norm(gate * (p[i] @ w_ple_proj[i]), ng[7])
    return x
```

```cpp
#include <hip/hip_runtime.h>
#include <cstdio>
#include <cstdint>

#define LAS __attribute__((address_space(3)))
typedef unsigned short bf16_t;
typedef short bf16x8 __attribute__((ext_vector_type(8)));
typedef short s16x4 __attribute__((ext_vector_type(4)));
typedef float f32x4 __attribute__((ext_vector_type(4)));
typedef float f32x2 __attribute__((ext_vector_type(2)));
typedef unsigned u32x4 __attribute__((ext_vector_type(4)));
typedef unsigned u32x2 __attribute__((ext_vector_type(2)));

namespace pg8 {
constexpr int BM = 256, BK = 64, HALF = 128, HTB = HALF * BK * 2, STAGE_BYTES = 8 * HTB, NXCD = 8, WGM = 8;
__host__ __device__ __forceinline__ int lds_byte(int r, int c) { const int st = (r >> 4) * 2 + (c >> 5), rr = r & 15, cc = c & 31, ob = rr * 64 + cc * 2; return st * 1024 + (ob ^ (((ob >> 9) & 1) << 5)); }
__host__ __device__ __forceinline__ void stage_rc(int b, int& R, int& C) { const int st = b / 1024, sb = b % 1024, swz = sb ^ (((sb >> 9) & 1) << 5); R = (st >> 1) * 16 + swz / 64; C = (st & 1) * 32 + (swz % 64) / 2; }
__host__ __device__ __forceinline__ int perm32(int rho) { const int n = rho >> 4, i = rho & 15; return 8 * (i >> 2) + 4 * n + (i & 3); }
struct Unit { int pm, pn; };
struct Gemm { const bf16_t* A; const bf16_t* Bt; int M, N, K; };
struct StaticOrder {
    int nM, nN, nwg, G, c;
    __host__ __device__ void init(int M, int N, int G_, int c_) { nM = M / BM; nN = N / BM; nwg = nM * nN; G = G_; c = c_; }
    __host__ __device__ bool next(int i, Unit& u) const {
        const long L = (long)i * G + c; if (L >= nwg) return false;
        int wgid = (int)L; { const int q = nwg / NXCD, r = nwg % NXCD, xcd = wgid % NXCD, off = wgid / NXCD; wgid = (xcd < r ? xcd * (q + 1) : r * (q + 1) + (xcd - r) * q) + off; }
        const int nig = WGM * nN, gid = wgid / nig, fm = gid * WGM, gsz = (nM - fm) < WGM ? (nM - fm) : WGM;
        u.pm = fm + ((wgid % nig) % gsz); u.pn = (wgid % nig) / gsz; return true;
    }
    __device__ __forceinline__ void a_ready(const Unit&) const {}
    __device__ __forceinline__ void done(const Unit&) const {}
};
__device__ __forceinline__ unsigned cvt_pk_bf16(float lo, float hi) { unsigned r; asm volatile("v_cvt_pk_bf16_f32 %0, %1, %2" : "=v"(r) : "v"(lo), "v"(hi)); return r; }

typedef int i32x4 __attribute__((ext_vector_type(4)));
typedef int i32x8 __attribute__((ext_vector_type(8)));
template <bool F8>
__device__ __forceinline__ void mma_blk(f32x4 (&c)[4][2], const bf16x8 (&At)[4][2], const bf16x8 (&Bt)[2][2]) {
    __builtin_amdgcn_s_setprio(1);
    if constexpr (F8) {
#pragma unroll
        for (int m = 0; m < 4; ++m)
#pragma unroll
            for (int n = 0; n < 2; ++n) {
                const i32x8 b8 = __builtin_shufflevector(__builtin_bit_cast(i32x4, Bt[n][0]), __builtin_bit_cast(i32x4, Bt[n][1]), 0, 1, 2, 3, 4, 5, 6, 7);
                const i32x8 a8 = __builtin_shufflevector(__builtin_bit_cast(i32x4, At[m][0]), __builtin_bit_cast(i32x4, At[m][1]), 0, 1, 2, 3, 4, 5, 6, 7);
                c[m][n] = __builtin_amdgcn_mfma_scale_f32_16x16x128_f8f6f4(b8, a8, c[m][n], 0, 0, 0, 0, 0, 0); }
    } else {
#pragma unroll
        for (int m = 0; m < 4; ++m)
#pragma unroll
            for (int n = 0; n < 2; ++n)
#pragma unroll
                for (int k = 0; k < 2; ++k) c[m][n] = __builtin_amdgcn_mfma_f32_16x16x32_bf16(Bt[n][k], At[m][k], c[m][n], 0, 0, 0);
    }
    __builtin_amdgcn_s_setprio(0);
}
template <class Epi, class Sched, bool ALIGN_EPI = false, bool SP2 = false, bool F8 = false>
__device__ __forceinline__ void gemm_phase(LAS unsigned char* lds, const Gemm g, const Sched& S, const Epi& E) {
    int tid_ = threadIdx.x; asm volatile("" : "+v"(tid_));
    const int tid = tid_, wid = __builtin_amdgcn_readfirstlane(tid >> 6), lane = tid & 63, wr = wid >> 2, wc = wid & 3, fr = lane & 15, fq = lane >> 4;
    const int K = g.K, nt = K / BK;
    unsigned voffA, voffB;
    { int R, C; stage_rc(tid * 16, R, C); const int Rb = Epi::PERM ? ((R & ~31) + perm32(R & 31)) : R;
      voffA = (unsigned)(R * K + C) * 2u; voffB = (unsigned)(Rb * K + C) * 2u; }
    const size_t rstep = (size_t)64 * K * 2;
    const size_t kstep = (size_t)(BK * 2);
    const size_t hstep = (size_t)HALF * K * 2;
    const size_t tstep = 2 * hstep;
    const unsigned ldsw = (unsigned)wid * 1024u;
    const int aoff = lds_byte(wr * 64 + fr, fq * 8), boff = lds_byte(wc * 32 + fr, fq * 8);
#define PG8_SA(b, h) (((b) * 2 + (h)) * HTB)
#define PG8_SB(b, h) ((4 + (b) * 2 + (h)) * HTB)
#define PG8_STAGE(bufoff, gbase, voff) do { _Pragma("unroll") for (int _i = 0; _i < 2; ++_i) { if constexpr (F8) asm volatile("" : "+v"(voff));     \
        __builtin_amdgcn_global_load_lds((const unsigned*)((const char*)(gbase) + _i * rstep + (voff)), (LAS unsigned*)(lds + (bufoff) + ldsw + _i * 8192), 16, 0, 0); } } while (0)
#define PG8_LDA(dst, b, h) do { _Pragma("unroll") for (int m = 0; m < 4; ++m) _Pragma("unroll") for (int k = 0; k < 2; ++k) dst[m][k] = *(const LAS bf16x8*)(lds + PG8_SA(b, h) + aoff + m * 2048 + k * 1024); } while (0)
#define PG8_LDB(dst, b, h) do { _Pragma("unroll") for (int n = 0; n < 2; ++n) _Pragma("unroll") for (int k = 0; k < 2; ++k) dst[n][k] = *(const LAS bf16x8*)(lds + PG8_SB(b, h) + boff + n * 2048 + k * 1024); } while (0)
#define PG8_MMA(ai, bj, At, Bt) mma_blk<F8>(acc[ai][bj], At, Bt)
#define PG8_WAIT_V(n) asm volatile("s_waitcnt vmcnt(" #n ")" ::: "memory")
#define PG8_WAIT_L(n) asm volatile("s_waitcnt lgkmcnt(" #n ")" ::: "memory")
#define PG8_BAR __builtin_amdgcn_s_barrier()
#define PG8_SCHED __builtin_amdgcn_sched_barrier(0)
    Unit cur, nxt; int ui = 0;
    if (!S.next(0, cur)) return;
    f32x4 acc[2][2][4][2];
#pragma unroll
    for (int a = 0; a < 2; ++a)
#pragma unroll
        for (int b = 0; b < 2; ++b)
#pragma unroll
            for (int m = 0; m < 4; ++m)
#pragma unroll
                for (int n = 0; n < 2; ++n) acc[a][b][m][n] = (f32x4){0.f, 0.f, 0.f, 0.f};
    bf16x8 At[4][2], B0[2][2], B1[2][2];
    const char* cA = (const char*)g.A + (size_t)cur.pm * tstep; const char* cB = (const char*)g.Bt + (size_t)cur.pn * tstep;
    S.a_ready(cur);
    if constexpr (SP2) {
        PG8_STAGE(PG8_SB(0, 0), cB, voffB); PG8_STAGE(PG8_SB(0, 1), cB + hstep, voffB); PG8_STAGE(PG8_SA(0, 0), cA, voffA); PG8_STAGE(PG8_SA(0, 1), cA + hstep, voffA);
        if (wr == 1) PG8_BAR;
        PG8_WAIT_V(2); PG8_BAR;
        PG8_STAGE(PG8_SB(1, 0), cB + kstep, voffB); PG8_STAGE(PG8_SA(1, 0), cA + kstep, voffA); PG8_STAGE(PG8_SB(1, 1), cB + hstep + kstep, voffB);
        PG8_WAIT_V(6); PG8_BAR;
    } else {
        PG8_STAGE(PG8_SB(0, 0), cB, voffB); PG8_STAGE(PG8_SA(0, 0), cA, voffA); PG8_STAGE(PG8_SB(0, 1), cB + hstep, voffB); PG8_STAGE(PG8_SA(0, 1), cA + hstep, voffA);
        if (wr == 1) PG8_BAR;
        PG8_WAIT_V(4); PG8_BAR;
        PG8_STAGE(PG8_SB(1, 0), cB + kstep, voffB); PG8_STAGE(PG8_SA(1, 0), cA + kstep, voffA); PG8_STAGE(PG8_SB(1, 1), cB + hstep + kstep, voffB);
        PG8_WAIT_V(6); PG8_BAR;
    }
    for (;;) {
        const bool has_next = S.next(ui + 1, nxt);
        const char* nA = has_next ? (const char*)g.A + (size_t)nxt.pm * tstep : cA; const char* nB = has_next ? (const char*)g.Bt + (size_t)nxt.pn * tstep : cB;
        for (int t = 0; t < nt; t += 2) {
            const bool last = (t == nt - 2);
            const char* a1 = cA + (size_t)(t + 1) * kstep;
            const char* a2 = last ? nA : cA + (size_t)(t + 2) * kstep; const char* b2 = last ? nB : cB + (size_t)(t + 2) * kstep;
            const char* a3 = a2 + kstep; const char* b3 = b2 + kstep;
            if (last && has_next) S.a_ready(nxt);
            if constexpr (SP2) {
            PG8_LDB(B0, 0, 0); PG8_LDB(B1, 0, 1); PG8_SCHED; PG8_LDA(At, 0, 0); PG8_STAGE(PG8_SA(1, 1), a1 + hstep, voffA);
            PG8_WAIT_V(8); PG8_WAIT_L(0); PG8_BAR; PG8_MMA(0, 0, At, B0); PG8_MMA(0, 1, At, B1); PG8_BAR; PG8_SCHED;
            PG8_LDA(At, 0, 1); PG8_STAGE(PG8_SB(0, 0), b2, voffB); PG8_STAGE(PG8_SB(0, 1), b2 + hstep, voffB); PG8_STAGE(PG8_SA(0, 0), a2, voffA);
            PG8_WAIT_V(8); PG8_WAIT_L(0); PG8_BAR; PG8_MMA(1, 0, At, B0); PG8_MMA(1, 1, At, B1); PG8_BAR; PG8_SCHED;
            PG8_LDB(B0, 1, 0); PG8_LDB(B1, 1, 1); PG8_SCHED; PG8_LDA(At, 1, 0); PG8_STAGE(PG8_SA(0, 1), a2 + hstep, voffA);
            PG8_WAIT_V(8); PG8_WAIT_L(0); PG8_BAR; PG8_MMA(0, 0, At, B0); PG8_MMA(0, 1, At, B1); PG8_BAR; PG8_SCHED;
            PG8_LDA(At, 1, 1); PG8_STAGE(PG8_SB(1, 0), b3, voffB); PG8_STAGE(PG8_SB(1, 1), b3 + hstep, voffB); PG8_STAGE(PG8_SA(1, 0), a3, voffA);
            PG8_WAIT_V(8); PG8_WAIT_L(0); PG8_BAR; PG8_MMA(1, 0, At, B0); PG8_MMA(1, 1, At, B1); PG8_BAR; PG8_SCHED;
            } else {
            PG8_LDB(B0, 0, 0); PG8_SCHED; PG8_LDA(At, 0, 0); PG8_STAGE(PG8_SA(1, 1), a1 + hstep, voffA);
            PG8_WAIT_L(8); PG8_BAR; PG8_WAIT_L(0); PG8_MMA(0, 0, At, B0); PG8_BAR; PG8_SCHED;
            PG8_LDB(B1, 0, 1); PG8_STAGE(PG8_SB(0, 0), b2, voffB);
            PG8_BAR; PG8_WAIT_L(0); PG8_MMA(0, 1, At, B1); PG8_BAR;
            PG8_LDA(At, 0, 1); PG8_STAGE(PG8_SA(0, 0), a2, voffA);
            PG8_BAR; PG8_WAIT_L(0); PG8_MMA(1, 0, At, B0); PG8_BAR; PG8_SCHED;
            PG8_STAGE(PG8_SB(0, 1), b2 + hstep, voffB);
            PG8_WAIT_V(6); PG8_BAR; PG8_MMA(1, 1, At, B1); PG8_BAR;
            PG8_LDB(B0, 1, 0); PG8_SCHED; PG8_LDA(At, 1, 0); PG8_STAGE(PG8_SA(0, 1), a2 + hstep, voffA);
            PG8_WAIT_L(8); PG8_BAR; PG8_WAIT_L(0); PG8_MMA(0, 0, At, B0); PG8_BAR; PG8_SCHED;
            PG8_LDB(B1, 1, 1); PG8_STAGE(PG8_SB(1, 0), b3, voffB);
            PG8_BAR; PG8_WAIT_L(0); PG8_MMA(0, 1, At, B1); PG8_BAR;
            PG8_LDA(At, 1, 1); PG8_STAGE(PG8_SA(1, 0), a3, voffA);
            PG8_BAR; PG8_WAIT_L(0); PG8_MMA(1, 0, At, B0); PG8_BAR; PG8_SCHED;
            PG8_STAGE(PG8_SB(1, 1), b3 + hstep, voffB);
            PG8_WAIT_V(6); PG8_BAR; PG8_MMA(1, 1, At, B1); PG8_BAR;
            }
        }
        if constexpr (ALIGN_EPI) { if (wr == 0) PG8_BAR; }
        { const int ln = __builtin_amdgcn_mbcnt_hi(~0u, __builtin_amdgcn_mbcnt_lo(~0u, 0u));
          E(acc, cur, wr, wc, ln & 15, ln >> 4); } S.done(cur);
        if (!has_next) break;
#pragma unroll
        for (int a = 0; a < 2; ++a)
#pragma unroll
            for (int b = 0; b < 2; ++b)
#pragma unroll
                for (int m = 0; m < 4; ++m)
#pragma unroll
                    for (int n = 0; n < 2; ++n) acc[a][b][m][n] = (f32x4){0.f, 0.f, 0.f, 0.f};
        cur = nxt; cA = nA; cB = nB; ++ui;
        if constexpr (ALIGN_EPI) { if (wr == 1) PG8_BAR; }
    }
    PG8_WAIT_V(0);
    if constexpr (!ALIGN_EPI) { if (wr == 0) PG8_BAR; }
    PG8_BAR;
#undef PG8_SA
#undef PG8_SB
#undef PG8_STAGE
#undef PG8_LDA
#undef PG8_LDB
#undef PG8_MMA
#undef PG8_WAIT_V
#undef PG8_WAIT_L
#undef PG8_BAR
#undef PG8_SCHED
}
}

constexpr int NB = 16, SEQ = 2048, D = 2048, M = NB * SEQ, FF = 5632, DEPTH = 4, PLE = 256;
constexpr float EPS = 1e-6f;
constexpr float QSCALE_MOBA = 0.08838834764831845f * 1.4426950408889634f;

constexpr size_t MiB = 1u << 20;
constexpr size_t WS_CTL = 0, WS_KSUM = 1 * MiB, CTL_ZERO_BYTES = 2 * MiB;
constexpr size_t WS_RCOS = 2 * MiB, WS_RSIN = 3 * MiB, WS_MCOS = 4 * MiB, WS_MSIN = 4 * MiB + 128 * 1024;
constexpr size_t WS_SGUW = 5 * MiB, WS_POOLW = 6 * MiB, WS_RS = 7 * MiB;
constexpr size_t WS_WGU = 8 * MiB, WS_WDN = 360 * MiB, WS_WINE = 536 * MiB, WS_WINO = 584 * MiB, WS_WOUT = 616 * MiB, WS_WPG = 648 * MiB, WS_WPP = 680 * MiB;
constexpr size_t WS_PBF = 684 * MiB, WS_H = 748 * MiB, WS_T = 876 * MiB, WS_Y = 1004 * MiB, WS_BIG = 1132 * MiB, WS_X8 = 1516 * MiB, WS_END = 1580 * MiB;
constexpr size_t SZ_WGU = (size_t)2 * FF * D * 2, SZ_WDN = (size_t)D * FF * 2;
constexpr int CW_BAR = 4096;

constexpr int RING_BYTES = 131072, LDS_BYTES = 147456, MISC_OFF = LDS_BYTES - 64;

#define XB_TMO      128
#define XB_XCNT(j)  (256  + 64 * (j))
#define XB_XSUB(j)  (1280 + 64 * (j))
#define XB_XGEN(j)  (2304 + 64 * (j))
#define XB_TOP      3328
#define XB_TOPGEN   3392
#define XCD_BAR_WORDS 3456
#define XB_SPIN_CAP (1u << 18)
__device__ __forceinline__ unsigned xb_ld(unsigned* p)              { return __hip_atomic_load(p, __ATOMIC_RELAXED, __HIP_MEMORY_SCOPE_AGENT); }
__device__ __forceinline__ unsigned xb_add(unsigned* p, unsigned v) { return __hip_atomic_fetch_add(p, v, __ATOMIC_RELAXED, __HIP_MEMORY_SCOPE_AGENT); }
__device__ __forceinline__ unsigned xb_xcc_id() { return (unsigned)__builtin_amdgcn_s_getreg((3 << 11) | 20) & 0xFu; }
#define XB_SPIN(cond, bar) do { unsigned _sp = 0; while (cond) { __builtin_amdgcn_s_sleep(1); \
    if ((++_sp & 255u) == 0u) { if (xb_ld(&(bar)[XB_TMO])) break; if (_sp > XB_SPIN_CAP) { atomicAdd(&(bar)[XB_TMO], 1u); break; } } } } while (0)
struct XcdBarrier { unsigned* bar; unsigned x; volatile LAS unsigned* st; };
__device__ __forceinline__ XcdBarrier xcd_barrier_post(unsigned* bar, volatile LAS unsigned* st) {
    XcdBarrier b; b.bar = bar; b.x = xb_xcc_id(); b.st = st;
    if (threadIdx.x == 0) (void)xb_add(&bar[XB_XCNT(b.x)], 1u);
    return b;
}
__device__ __forceinline__ void xcd_barrier_complete(unsigned* bar, unsigned x, unsigned& nloc, unsigned& nx) {
    const unsigned G = gridDim.x * gridDim.y * gridDim.z;
    unsigned sum, cnt, mine, sp = 0u;
    for (;;) {
        sum = 0u; cnt = 0u; mine = 0u;
#pragma unroll
        for (unsigned j = 0; j < 16; ++j) { const unsigned c = xb_ld(&bar[XB_XCNT(j)]); sum += c; cnt += (c > 0u) ? 1u : 0u; mine = (j == x) ? c : mine; }
        if (sum == G) break;
        __builtin_amdgcn_s_sleep(1);
        if ((++sp & 255u) == 0u) { if (xb_ld(&bar[XB_TMO])) break; if (sp > XB_SPIN_CAP) { atomicAdd(&bar[XB_TMO], 1u); break; } }
    }
    nloc = mine > 0u ? mine : 1u; nx = cnt > 0u ? cnt : 1u;
}
__device__ __forceinline__ void xcd_barrier(const XcdBarrier& b) {
    asm volatile("s_waitcnt vmcnt(0)" ::: "memory");
    __syncthreads();
    if (threadIdx.x == 0) {
        unsigned* bar = b.bar;
        __builtin_amdgcn_s_waitcnt(0);
        unsigned nloc = b.st[0], nx = b.st[1];
        if (nloc == 0u) { xcd_barrier_complete(bar, b.x, nloc, nx); b.st[0] = nloc; b.st[1] = nx; }
        const unsigned old = xb_add(&bar[XB_XSUB(b.x)], 1u);
        const unsigned gen = old / nloc;
        if (old + 1u == (gen + 1u) * nloc) {
            __builtin_amdgcn_fence(__ATOMIC_RELEASE, "agent");
            asm volatile("s_waitcnt vmcnt(0)" ::: "memory");
            const unsigned og = xb_add(&bar[XB_TOP], 1u);
            const unsigned tg = og / nx;
            if (og + 1u == (tg + 1u) * nx) xb_add(&bar[XB_TOPGEN], 1u);
            else XB_SPIN(xb_ld(&bar[XB_TOPGEN]) == tg, bar);
            __builtin_amdgcn_fence(__ATOMIC_ACQUIRE, "agent");
            xb_add(&bar[XB_XGEN(b.x)], 1u);
            asm volatile("s_waitcnt vmcnt(0)" ::: "memory");
        } else {
            XB_SPIN(xb_ld(&bar[XB_XGEN(b.x)]) == gen, bar);
            __builtin_amdgcn_fence(__ATOMIC_ACQUIRE, "agent");
            asm volatile("s_waitcnt vmcnt(0)" ::: "memory");
        }
    }
    __syncthreads();
}

#define LDS_WAIT() asm volatile("s_waitcnt lgkmcnt(0)" ::: "memory")
__device__ __forceinline__ unsigned f2bf(float f) { unsigned u = __builtin_bit_cast(unsigned, f); return (u + 0x7fffu + ((u >> 16) & 1u)) >> 16; }
__device__ __forceinline__ unsigned pk2(float lo, float hi) { return f2bf(lo) | (f2bf(hi) << 16); }
__device__ __forceinline__ float bf_lo(unsigned w) { return __builtin_bit_cast(float, w << 16); }
__device__ __forceinline__ float bf_hi(unsigned w) { return __builtin_bit_cast(float, w & 0xffff0000u); }
__device__ __forceinline__ float wave_sum(float v) {
#pragma unroll
    for (int o = 1; o < 64; o <<= 1) v += __shfl_xor(v, o);
    return v;
}
__device__ __forceinline__ float silu_f(float x) { return x * __builtin_amdgcn_rcpf(1.f + __expf(-x)); }
__device__ __forceinline__ float sigmoid_f(float x) { return __builtin_amdgcn_rcpf(1.f + __expf(-x)); }
__device__ __forceinline__ float gelu_tanh_f(float x) {
    const float u = 0.7978845608028654f * (x + 0.044715f * x * x * x);
    return x * __builtin_amdgcn_rcpf(1.f + __expf(-2.f * u));
}
__device__ __forceinline__ f32x2 rcp_pk(f32x2 d) { f32x2 r; r.x = __builtin_amdgcn_rcpf(d.x); r.y = __builtin_amdgcn_rcpf(d.y); return r; }
__device__ __forceinline__ f32x2 exp2_pk(f32x2 t) { f32x2 e; e.x = __builtin_amdgcn_exp2f(t.x); e.y = __builtin_amdgcn_exp2f(t.y); return e; }
__device__ __forceinline__ f32x2 sigmoid_pk(f32x2 x) { return rcp_pk(exp2_pk(x * (-1.4426950408889634f)) + 1.0f); }
__device__ __forceinline__ f32x2 gelu_tanh_pk(f32x2 x) {
    const f32x2 p = (x * x) * (-0.10294324f) + (-2.3022082f);
    return x * rcp_pk(exp2_pk(x * p) + 1.0f);
}
__device__ __forceinline__ f32x4 silu_mul4(const f32x4& g, const f32x4& u) {
    const f32x2 g0 = (f32x2){g[0], g[1]}, g1 = (f32x2){g[2], g[3]}, u0 = (f32x2){u[0], u[1]}, u1 = (f32x2){u[2], u[3]};
    const f32x2 o0 = (g0 * u0) * sigmoid_pk(g0), o1 = (g1 * u1) * sigmoid_pk(g1);
    return (f32x4){o0.x, o0.y, o1.x, o1.y};
}
__device__ __forceinline__ f32x4 silu_mul4r(const f32x4& g, const f32x4& u, float c, float ir2) {
    f32x4 o;
#pragma unroll
    for (int i = 0; i < 4; ++i) { const float e = __builtin_amdgcn_exp2f((g[i] * c));
        o[i] = (g[i] * u[i]) * __builtin_amdgcn_rcpf(__builtin_fmaf(e, ir2, ir2)); }
    return o;
}
__device__ __forceinline__ f32x4 silu4r(const f32x4& a, float c, float ir) {
    f32x4 o;
#pragma unroll
    for (int i = 0; i < 4; ++i) o[i] = a[i] * __builtin_amdgcn_rcpf(__builtin_fmaf(__builtin_amdgcn_exp2f(a[i] * c), ir, ir));
    return o;
}
__device__ __forceinline__ f32x4 gelu4r(const f32x4& a, float Ar, float Br3, float ir) {
    f32x4 o;
#pragma unroll
    for (int i = 0; i < 4; ++i) o[i] = a[i] * __builtin_amdgcn_rcpf(__builtin_fmaf(__builtin_amdgcn_exp2f(a[i] * __builtin_fmaf(a[i] * a[i], Br3, Ar)), ir, ir));
    return o;
}
__device__ __forceinline__ f32x4 silu4(const f32x4& g) {
    const f32x2 g0 = (f32x2){g[0], g[1]}, g1 = (f32x2){g[2], g[3]};
    const f32x2 o0 = g0 * sigmoid_pk(g0), o1 = g1 * sigmoid_pk(g1);
    return (f32x4){o0.x, o0.y, o1.x, o1.y};
}
__device__ __forceinline__ f32x4 gelu4(const f32x4& x) {
    const f32x2 o0 = gelu_tanh_pk((f32x2){x[0], x[1]}), o1 = gelu_tanh_pk((f32x2){x[2], x[3]});
    return (f32x4){o0.x, o0.y, o1.x, o1.y};
}
__device__ __forceinline__ f32x4 sigmoid_mul4r(const f32x4& a, float c, float p0, float p1, float p2, float p3) {
    f32x4 o;
    o[0] = p0 * __builtin_amdgcn_rcpf(1.0f + __builtin_amdgcn_exp2f(a[0] * c)); o[1] = p1 * __builtin_amdgcn_rcpf(1.0f + __builtin_amdgcn_exp2f(a[1] * c));
    o[2] = p2 * __builtin_amdgcn_rcpf(1.0f + __builtin_amdgcn_exp2f(a[2] * c)); o[3] = p3 * __builtin_amdgcn_rcpf(1.0f + __builtin_amdgcn_exp2f(a[3] * c));
    return o;
}
__device__ __forceinline__ f32x4 sigmoid_mul4(const f32x4& a, float p0, float p1, float p2, float p3) {
    const f32x2 o0 = sigmoid_pk((f32x2){a[0], a[1]}) * (f32x2){p0, p1}, o1 = sigmoid_pk((f32x2){a[2], a[3]}) * (f32x2){p2, p3};
    return (f32x4){o0.x, o0.y, o1.x, o1.y};
}
__device__ __forceinline__ u32x4 pack8(const f32x4& a, const f32x4& b) {
    u32x4 w; w.x = pg8::cvt_pk_bf16(a[0], a[1]); w.y = pg8::cvt_pk_bf16(a[2], a[3]); w.z = pg8::cvt_pk_bf16(b[0], b[1]); w.w = pg8::cvt_pk_bf16(b[2], b[3]); return w;
}

#ifndef GU_F8_MASK
#define GU_F8_MASK 0xE0
#endif
#ifndef DN_F8_MASK
#define DN_F8_MASK 0xE0
#endif
__device__ __forceinline__ float ld_rs(const float* rs, int row0, int imm) { return *(const float*)((const unsigned char*)rs + ((unsigned)row0 << 2) + (unsigned)(imm * 4)); }
typedef f32x4 AccT[2][2][4][2];
struct EpiPlain {
    static constexpr bool PERM = true;
    bf16_t* O; int ldc; int gelu_pm;
    __device__ __forceinline__ void operator()(const AccT& acc, const pg8::Unit& u, int wr, int wc, int fr, int fq) const {
        const int row0 = u.pm * 256 + wr * 64 + fr, col0 = u.pn * 256 + wc * 32 + 8 * fq;
        const bool gl = u.pm >= gelu_pm;
#pragma unroll
        for (int ai = 0; ai < 2; ++ai)
#pragma unroll
            for (int m = 0; m < 4; ++m) { bf16_t* rowp = O + (size_t)(row0 + ai * 128 + m * 16) * ldc + col0;
#pragma unroll
                for (int bj = 0; bj < 2; ++bj) { f32x4 v0 = acc[ai][bj][m][0], v1 = acc[ai][bj][m][1];
                    if (gl) { v0 = gelu4(v0); v1 = gelu4(v1); }
                    *(u32x4*)(rowp + bj * 128) = pack8(v0, v1); } }
    }
};
struct EpiPlainT {
    static constexpr bool PERM = true;
    bf16_t* O; int ldc; int gelu_pm; const float* rs;
    __device__ __forceinline__ void operator()(const AccT& acc, const pg8::Unit& u, int wr, int wc, int fr, int fq) const {
        const int row0 = u.pm * 256 + wr * 64 + fr, col0 = u.pn * 256 + wc * 32 + 8 * fq;
        const bool gl = u.pm >= gelu_pm;
        f32x4 cs[2][2];
#pragma unroll
        for (int bj = 0; bj < 2; ++bj)
#pragma unroll
            for (int n = 0; n < 2; ++n) cs[bj][n] = *(const f32x4*)(rs + col0 + bj * 128 + 4 * n);
#pragma unroll
        for (int ai = 0; ai < 2; ++ai)
#pragma unroll
            for (int m = 0; m < 4; ++m) { bf16_t* rowp = O + (size_t)(row0 + ai * 128 + m * 16) * ldc + col0;
#pragma unroll
                for (int bj = 0; bj < 2; ++bj) { f32x4 v0 = acc[ai][bj][m][0] * cs[bj][0], v1 = acc[ai][bj][m][1] * cs[bj][1];
                    if (gl) { v0 = gelu4(v0); v1 = gelu4(v1); }
                    *(u32x4*)(rowp + bj * 128) = pack8(v0, v1); } }
    }
};
struct EpiGU {
    static constexpr bool PERM = true;
    bf16_t* O; const float* rs;
    __device__ __forceinline__ void operator()(const AccT& acc, const pg8::Unit& u, int wr, int wc, int fr, int fq) const {
        const int row0 = u.pm * 256 + wr * 64 + fr, col0 = u.pn * 128 + wc * 32 + 8 * fq;
        float rv[2][4];
#pragma unroll
        for (int ai = 0; ai < 2; ++ai)
#pragma unroll
            for (int m = 0; m < 4; ++m) rv[ai][m] = ld_rs(rs, row0, ai * 128 + m * 16);
#pragma unroll
        for (int ai = 0; ai < 2; ++ai)
#pragma unroll
            for (int m = 0; m < 4; ++m) { bf16_t* rowp = O + (size_t)(row0 + ai * 128 + m * 16) * FF + col0; const float r = rv[ai][m], c = r * -1.4426950408889634f, r2 = __builtin_amdgcn_rcpf(r * r);
                const f32x4 o0 = silu_mul4r(acc[ai][0][m][0], acc[ai][1][m][0], c, r2), o1 = silu_mul4r(acc[ai][0][m][1], acc[ai][1][m][1], c, r2);
                *(u32x4*)rowp = pack8(o0, o1); }
    }
};
__host__ __device__ constexpr bool dn_f8(int L, int f) { return (DN_F8_MASK >> (L * 2 + f)) & 1; }
__host__ __device__ constexpr bool gu_f8(int L, int f) { return (GU_F8_MASK >> (L * 2 + f)) & 1; }
static_assert((GU_F8_MASK & ~DN_F8_MASK) == 0, "an fp8 gate/up GEMM writes fp8 output: its down GEMM must be fp8 as well");
constexpr float F8_XSCALE = 8.f, F8_WGSCALE = 128.f;
constexpr float F8_ASCALE = 8.f, F8_WSCALE = 256.f;
__device__ __forceinline__ unsigned pack4_fp8(const f32x4& v) {
    int w = 0;
    w = __builtin_amdgcn_cvt_pk_fp8_f32(__builtin_amdgcn_fmed3f(v[0], -448.f, 448.f), __builtin_amdgcn_fmed3f(v[1], -448.f, 448.f), w, false);
    w = __builtin_amdgcn_cvt_pk_fp8_f32(__builtin_amdgcn_fmed3f(v[2], -448.f, 448.f), __builtin_amdgcn_fmed3f(v[3], -448.f, 448.f), w, true);
    return (unsigned)w;
}
struct EpiGU8 {
    static constexpr bool PERM = true;
    unsigned char* O; const float* rs; float sc;
    __device__ __forceinline__ void operator()(const AccT& acc, const pg8::Unit& u, int wr, int wc, int fr, int fq) const {
        asm volatile("" : "+v"(fr), "+v"(fq));
        const int row0 = u.pm * 256 + wr * 64 + fr, col0 = u.pn * 128 + wc * 32 + 8 * fq;
        float rv[2][4];
#pragma unroll
        for (int ai = 0; ai < 2; ++ai)
#pragma unroll
            for (int m = 0; m < 4; ++m) rv[ai][m] = ld_rs(rs, row0, ai * 128 + m * 16);
#pragma unroll
        for (int ai = 0; ai < 2; ++ai)
#pragma unroll
            for (int m = 0; m < 4; ++m) { unsigned char* rowp = O + (size_t)(row0 + ai * 128 + m * 16) * FF + col0; const float r = rv[ai][m] * sc, c = r * -1.4426950408889634f, r2 = __builtin_amdgcn_rcpf(r * r * F8_ASCALE);
                const f32x4 o0 = silu_mul4r(acc[ai][0][m][0], acc[ai][1][m][0], c, r2), o1 = silu_mul4r(acc[ai][0][m][1], acc[ai][1][m][1], c, r2);
                u32x2 w; w.x = pack4_fp8(o0); w.y = pack4_fp8(o1);
                *(u32x2*)rowp = w; }
    }
};
struct EpiPlainS {
    static constexpr bool PERM = true;
    bf16_t* O; int ldc; float sc;
    __device__ __forceinline__ void operator()(const AccT& acc, const pg8::Unit& u, int wr, int wc, int fr, int fq) const {
        asm volatile("" : "+v"(fr), "+v"(fq));
        const int row0 = u.pm * 256 + wr * 64 + fr, col0 = u.pn * 256 + wc * 32 + 8 * fq;
#pragma unroll
        for (int ai = 0; ai < 2; ++ai)
#pragma unroll
            for (int m = 0; m < 4; ++m) { bf16_t* rowp = O + (size_t)(row0 + ai * 128 + m * 16) * ldc + col0;
#pragma unroll
                for (int bj = 0; bj < 2; ++bj) *(u32x4*)(rowp + bj * 128) = pack8(acc[ai][bj][m][0] * sc, acc[ai][bj][m][1] * sc); }
    }
};
struct EpiInEven {
    static constexpr bool PERM = true;
    bf16_t* O; const float* rcos; const float* rsin; const float* rs;
    __device__ __forceinline__ void operator()(const AccT& acc, const pg8::Unit& u, int wr, int wc, int fr, int fq) const {
        const int row0 = u.pm * 256 + wr * 64 + fr, col0 = u.pn * 256 + wc * 32 + 8 * fq;
        float rv[2][4];
#pragma unroll
        for (int ai = 0; ai < 2; ++ai)
#pragma unroll
            for (int m = 0; m < 4; ++m) rv[ai][m] = ld_rs(rs, row0, ai * 128 + m * 16);
        if (u.pn < 8) {
            const float ksc = u.pn >= 4 ? 0.0625f : 1.f;
#pragma unroll
            for (int ai = 0; ai < 2; ++ai) { f32x4 ctab[4][2], stab[4][2];
#pragma unroll
                for (int m = 0; m < 4; ++m)
#pragma unroll
                    for (int n = 0; n < 2; ++n) { const int tp = (row0 + ai * 128 + m * 16) & (SEQ - 1), i0 = wc * 32 + 8 * fq + 4 * n; ctab[m][n] = *(const f32x4*)(rcos + tp * 128 + i0); stab[m][n] = *(const f32x4*)(rsin + tp * 128 + i0); }
#pragma unroll
                for (int m = 0; m < 4; ++m) { const int row = row0 + ai * 128 + m * 16; bf16_t* rowp = O + (size_t)row * 4096 + col0;
                    f32x4 o1[2], o2[2]; const float kr = ksc * rv[ai][m];
#pragma unroll
                    for (int n = 0; n < 2; ++n) {
                        const f32x4 c4 = ctab[m][n], s4 = stab[m][n];
                        const f32x4 x1 = acc[ai][0][m][n], x2 = acc[ai][1][m][n];
                        o1[n] = (x1 * c4 - x2 * s4) * kr; o2[n] = (x2 * c4 + x1 * s4) * kr; }
                    *(u32x4*)rowp = pack8(o1[0], o1[1]); *(u32x4*)(rowp + 128) = pack8(o2[0], o2[1]); } }
        } else {
            const bool is_g = u.pn < 12;
#pragma unroll
            for (int ai = 0; ai < 2; ++ai)
#pragma unroll
                for (int m = 0; m < 4; ++m) { bf16_t* rowp = O + (size_t)(row0 + ai * 128 + m * 16) * 4096 + col0;
#pragma unroll
                    for (int bj = 0; bj < 2; ++bj) { f32x4 v0, v1; const float r = rv[ai][m], ir = __builtin_amdgcn_rcpf(r);
                        if (is_g) { const float c = r * -1.4426950408889634f; v0 = silu4r(acc[ai][bj][m][0], c, ir); v1 = silu4r(acc[ai][bj][m][1], c, ir); }
                        else { const float Ar = r * -2.3022082f, Br3 = r * r * r * -0.10294324f; v0 = gelu4r(acc[ai][bj][m][0], Ar, Br3, ir); v1 = gelu4r(acc[ai][bj][m][1], Ar, Br3, ir); }
                        *(u32x4*)(rowp + bj * 128) = pack8(v0, v1); } }
        }
    }
};
struct EpiInOdd {
    static constexpr bool PERM = true;
    bf16_t* O; const float* mcos; const float* msin; float* ksum; const float* rs;
    __device__ __forceinline__ void operator()(const AccT& acc, const pg8::Unit& u, int wr, int wc, int fr, int fq) const {
        const int row0 = u.pm * 256 + wr * 64 + fr, col0 = u.pn * 256 + wc * 32 + 8 * fq;
        const bool rot = (u.pn >= 4) && (wc == 0);
        const float sc = (u.pn >= 4 && u.pn < 8) ? QSCALE_MOBA : 1.f;
        f32x4 cs[2][2];
#pragma unroll
        for (int bj = 0; bj < 2; ++bj)
#pragma unroll
            for (int n = 0; n < 2; ++n) cs[bj][n] = (f32x4){0.f, 0.f, 0.f, 0.f};
#pragma unroll
        for (int ai = 0; ai < 2; ++ai)
#pragma unroll
          for (int mh = 0; mh < 2; ++mh) { f32x4 ctab[2][2], stab[2][2]; float rsv[2];
#pragma unroll
            for (int m2 = 0; m2 < 2; ++m2) rsv[m2] = ld_rs(rs, row0, ai * 128 + (2 * mh + m2) * 16);
            if (rot) {
#pragma unroll
                for (int m2 = 0; m2 < 2; ++m2)
#pragma unroll
                    for (int n = 0; n < 2; ++n) { const int tp = (row0 + ai * 128 + (2 * mh + m2) * 16) & (SEQ - 1), fi = (8 * fq + 4 * n) & 15; ctab[m2][n] = *(const f32x4*)(mcos + tp * 16 + fi); stab[m2][n] = *(const f32x4*)(msin + tp * 16 + fi); } }
#pragma unroll
            for (int m2 = 0; m2 < 2; ++m2) { const int m = 2 * mh + m2; const int row = row0 + ai * 128 + m * 16; bf16_t* rowp = O + (size_t)row * 3072 + col0; const float scr_ = sc * rsv[m2];
#pragma unroll
                for (int bj = 0; bj < 2; ++bj) { f32x4 v[2];
#pragma unroll
                    for (int n = 0; n < 2; ++n) { v[n] = acc[ai][bj][m][n];
                        if (rot) { f32x4 vp;
#pragma unroll
                            for (int j = 0; j < 4; ++j) vp[j] = __shfl_xor(v[n][j], 32);
                            const f32x4 c4 = ctab[m2][n], s4 = stab[m2][n];
                            v[n] = (fq < 2) ? (v[n] * c4 - vp * s4) : (v[n] * c4 + vp * s4); }
                        v[n] = v[n] * scr_; cs[bj][n] += v[n]; }
                    *(u32x4*)(rowp + bj * 128) = pack8(v[0], v[1]); } } }
        if (u.pn >= 8) {
#pragma unroll
            for (int bj = 0; bj < 2; ++bj)
#pragma unroll
                for (int n = 0; n < 2; ++n)
#pragma unroll
                    for (int j = 0; j < 4; ++j) { float s = cs[bj][n][j];
                        s += __shfl_xor(s, 1); s += __shfl_xor(s, 2); s += __shfl_xor(s, 4); s += __shfl_xor(s, 8);
                        if (fr == 0) atomicAdd(ksum + (size_t)u.pm * 1024 + (u.pn - 8) * 256 + bj * 128 + wc * 32 + 8 * fq + 4 * n + j, s); }
        }
    }
};
struct EpiPleGate {
    static constexpr bool PERM = true;
    bf16_t* O; const bf16_t* P; const float* rs;
    __device__ __forceinline__ void operator()(const AccT& acc, const pg8::Unit& u, int wr, int wc, int fr, int fq) const {
        const int row0 = u.pm * 256 + wr * 64 + fr, col0 = u.pn * 256 + wc * 32 + 8 * fq;
#pragma unroll
        for (int ai = 0; ai < 2; ++ai) { u32x4 pwv[4][2]; float rv[4];
#pragma unroll
            for (int m = 0; m < 4; ++m) rv[m] = ld_rs(rs, row0, ai * 128 + m * 16);
#pragma unroll
            for (int m = 0; m < 4; ++m)
#pragma unroll
                for (int bj = 0; bj < 2; ++bj) pwv[m][bj] = *(const u32x4*)(P + (size_t)(row0 + ai * 128 + m * 16) * D + col0 + bj * 128);
#pragma unroll
            for (int m = 0; m < 4; ++m) { const size_t off = (size_t)(row0 + ai * 128 + m * 16) * D + col0;
#pragma unroll
                for (int bj = 0; bj < 2; ++bj) { const u32x4 pw = pwv[m][bj]; const float c = rv[m] * -1.4426950408889634f;
                    const f32x4 v0 = sigmoid_mul4r(acc[ai][bj][m][0], c, bf_lo(pw.x), bf_hi(pw.x), bf_lo(pw.y), bf_hi(pw.y)), v1 = sigmoid_mul4r(acc[ai][bj][m][1], c, bf_lo(pw.z), bf_hi(pw.z), bf_lo(pw.w), bf_hi(pw.w));
                    *(u32x4*)(O + off + bj * 128) = pack8(v0, v1); } } }
    }
};

__device__ __forceinline__ int map_row(int mode, int n0) {
    if (mode == 1) return 256 * (n0 >> 7) + (n0 & 127);
    if (mode == 2) return 256 * (n0 >> 7) + 128 + (n0 & 127);
    if (mode == 3) { if (n0 < 2048) return n0; if (n0 < 3072) return n0 + 2048; if (n0 < 5120) return n0 - 1024; return n0; }
    return n0;
}
__device__ __forceinline__ void xpose_matrix(const float* W, int K, int N, bf16_t* WT, int mode, LAS float* scr, int gw, int NGW, int lane, const float* gain = nullptr) {
    const int nblk = N / 32, nitems = (K / 64) * nblk;
    for (int item = gw; item < nitems; item += NGW) {
        const int kb = item / nblk, nb = item % nblk, k0 = 64 * kb, n0 = 32 * nb, r0 = map_row(mode, n0);
#pragma unroll 8
        for (int i = 0; i < 32; ++i) { const int kk = 2 * i + (lane >> 5); scr[kk * 33 + (lane & 31)] = W[(size_t)(k0 + kk) * N + n0 + (lane & 31)]; }
        LDS_WAIT(); asm volatile("" ::: "memory");
        const int c = lane & 7;
        f32x4 g0 = (f32x4){1.f, 1.f, 1.f, 1.f}, g1 = g0;
        if (gain) { g0 = *(const f32x4*)(gain + k0 + 8 * c); g1 = *(const f32x4*)(gain + k0 + 8 * c + 4); }
#pragma unroll
        for (int j = 0; j < 4; ++j) { const int n = (lane >> 3) + 8 * j; const LAS float* s = scr + (8 * c) * 33 + n;
            u32x4 o; o.x = pk2(s[0 * 33] * g0[0], s[1 * 33] * g0[1]); o.y = pk2(s[2 * 33] * g0[2], s[3 * 33] * g0[3]); o.z = pk2(s[4 * 33] * g1[0], s[5 * 33] * g1[1]); o.w = pk2(s[6 * 33] * g1[2], s[7 * 33] * g1[3]);
            *(u32x4*)(WT + (size_t)(r0 + n) * K + k0 + 8 * c) = o; }
        LDS_WAIT(); asm volatile("" ::: "memory");
    }
}

__device__ __forceinline__ void xpose_matrix_f8(const float* W, int K, int N, unsigned char* WT, float scale, LAS float* scr, int gw, int NGW, int lane, int mode = 0, const float* gain = nullptr) {
    const int nblk = N / 32, nitems = (K / 64) * nblk;
    for (int item = gw; item < nitems; item += NGW) {
        const int kb = item / nblk, nb = item % nblk, k0 = 64 * kb, n0 = 32 * nb, r0 = map_row(mode, n0);
#pragma unroll 8
        for (int i = 0; i < 32; ++i) { const int kk = 2 * i + (lane >> 5); scr[kk * 33 + (lane & 31)] = W[(size_t)(k0 + kk) * N + n0 + (lane & 31)]; }
        LDS_WAIT(); asm volatile("" ::: "memory");
        const int c = lane & 7;
        f32x4 g0 = (f32x4){scale, scale, scale, scale}, g1 = g0;
        if (gain) { g0 = *(const f32x4*)(gain + k0 + 8 * c) * scale; g1 = *(const f32x4*)(gain + k0 + 8 * c + 4) * scale; }
#pragma unroll
        for (int j = 0; j < 4; ++j) { const int n = (lane >> 3) + 8 * j; const LAS float* s = scr + (8 * c) * 33 + n;
            u32x2 o; o.x = pack4_fp8((f32x4){s[0 * 33], s[1 * 33], s[2 * 33], s[3 * 33]} * g0); o.y = pack4_fp8((f32x4){s[4 * 33], s[5 * 33], s[6 * 33], s[7 * 33]} * g1);
            *(u32x2*)(WT + (size_t)(r0 + n) * K + k0 + 8 * c) = o; }
        LDS_WAIT(); asm volatile("" ::: "memory");
    }
}

template <bool HAS_T, bool XIN_F32 = true, bool XOUT_F32 = true>
__device__ __forceinline__ void rphase(const void* xin_, void* xout_, const bf16_t* T, float alpha, const float* gt, float* RS, int gw, int NGW, int lane, unsigned char* X8 = nullptr) {
    f32x4 gtv[8];
#pragma unroll
    for (int c = 0; c < 4; ++c) {
        if (HAS_T) { gtv[2 * c] = *(const f32x4*)(gt + 512 * c + 8 * lane); gtv[2 * c + 1] = *(const f32x4*)(gt + 512 * c + 8 * lane + 4); } }
    for (int row = gw; row < M; row += NGW) {
        f32x4 xv[8];
        if (XIN_F32) { const float* xr = (const float*)xin_ + (size_t)row * D + 8 * lane;
#pragma unroll
            for (int c = 0; c < 4; ++c) { xv[2 * c] = *(const f32x4*)(xr + 512 * c); xv[2 * c + 1] = *(const f32x4*)(xr + 512 * c + 4); }
        } else { const bf16_t* xr = (const bf16_t*)xin_ + (size_t)row * D + 8 * lane; u32x4 xw[4];
#pragma unroll
            for (int c = 0; c < 4; ++c) xw[c] = *(const u32x4*)(xr + 512 * c);
#pragma unroll
            for (int c = 0; c < 4; ++c) { xv[2 * c] = (f32x4){bf_lo(xw[c].x), bf_hi(xw[c].x), bf_lo(xw[c].y), bf_hi(xw[c].y)}; xv[2 * c + 1] = (f32x4){bf_lo(xw[c].z), bf_hi(xw[c].z), bf_lo(xw[c].w), bf_hi(xw[c].w)}; } }
        if (HAS_T) {
            u32x4 tv[4];
            const bf16_t* tr = T + (size_t)row * D + 8 * lane;
#pragma unroll
            for (int c = 0; c < 4; ++c) tv[c] = *(const u32x4*)(tr + 512 * c);
            f32x4 tf[8]; float ss = 0.f;
#pragma unroll
            for (int c = 0; c < 4; ++c) { tf[2 * c] = (f32x4){bf_lo(tv[c].x), bf_hi(tv[c].x), bf_lo(tv[c].y), bf_hi(tv[c].y)}; tf[2 * c + 1] = (f32x4){bf_lo(tv[c].z), bf_hi(tv[c].z), bf_lo(tv[c].w), bf_hi(tv[c].w)}; }
#pragma unroll
            for (int c = 0; c < 8; ++c) ss += (tf[c][0] * tf[c][0] + tf[c][1] * tf[c][1]) + (tf[c][2] * tf[c][2] + tf[c][3] * tf[c][3]);
            ss = wave_sum(ss);
            const float r = __builtin_amdgcn_rsqf(ss * (1.f / D) + EPS) * alpha;
#pragma unroll
            for (int c = 0; c < 4; ++c) { const f32x4 g0 = gtv[2 * c], g1 = gtv[2 * c + 1];
                xv[2 * c] += tf[2 * c] * g0 * r; xv[2 * c + 1] += tf[2 * c + 1] * g1 * r;
                if (XOUT_F32) { float* xo = (float*)xout_ + (size_t)row * D + 8 * lane; *(f32x4*)(xo + 512 * c) = xv[2 * c]; *(f32x4*)(xo + 512 * c + 4) = xv[2 * c + 1]; }
                else { bf16_t* xo = (bf16_t*)xout_ + (size_t)row * D + 8 * lane; *(u32x4*)(xo + 512 * c) = pack8(xv[2 * c], xv[2 * c + 1]); } }
        }
        if (!HAS_T) { bf16_t* xo = (bf16_t*)xout_ + (size_t)row * D + 8 * lane;
#pragma unroll
            for (int c = 0; c < 4; ++c) *(u32x4*)(xo + 512 * c) = pack8(xv[2 * c], xv[2 * c + 1]); }
        if (X8) { unsigned char* x8 = X8 + (size_t)row * D + 8 * lane;
#pragma unroll
            for (int c = 0; c < 4; ++c) { u32x2 w; w.x = pack4_fp8(xv[2 * c] * F8_XSCALE); w.y = pack4_fp8(xv[2 * c + 1] * F8_XSCALE); *(u32x2*)(x8 + 512 * c) = w; } }
        if (RS) {
            float s2 = 0.f;
#pragma unroll
            for (int c = 0; c < 8; ++c) s2 += (xv[c][0] * xv[c][0] + xv[c][1] * xv[c][1]) + (xv[c][2] * xv[c][2] + xv[c][3] * xv[c][3]);
            s2 = wave_sum(s2);
            if (lane == 0) RS[row] = __builtin_amdgcn_rsqf(s2 * (1.f / D) + EPS);
        }
    }
}

#define MFMA16(a, b, c) __builtin_amdgcn_mfma_f32_16x16x32_bf16((a), (b), (c), 0, 0, 0)

__device__ __forceinline__ void ret_tile(LAS unsigned char* lds, const bf16_t* Zn, const bf16_t* ZT, bf16_t* Y, int b, int h, int qt, int tid, int wid, int lane) {
    asm volatile("" : "+v"(tid), "+v"(lane));
    constexpr int KST = 544, VST = 144, OFF_V = 64 * KST, BUF = OFF_V + 256 * VST;
    const int r = lane & 15, q4 = lane >> 4;
    const int R0 = b * SEQ + qt * 128, t0w = qt * 128 + wid * 16;
    const float lg = __log2f(1.0f - exp2f(-5.0f - (float)h));
    bf16x8 qf[8];
    { const bf16_t* qrow = Zn + (size_t)(R0 + wid * 16 + r) * 4096 + h * 256 + q4 * 8;
#pragma unroll
      for (int kk = 0; kk < 8; ++kk) qf[kk] = *(const bf16x8*)(qrow + kk * 32); }
    f32x4 o[16];
#pragma unroll
    for (int e = 0; e < 16; ++e) o[e] = (f32x4){0.f, 0.f, 0.f, 0.f};
    const int nkt = 2 * (qt + 1);
    u32x4 pk[4], pv[4];
    const bf16_t* kbase = Zn + (size_t)(b * SEQ) * 4096 + 1024 + h * 256;
    const bf16_t* vbase = ZT + (size_t)(h * 256) * M + b * SEQ;
#define RET_PREFETCH(kt) do { _Pragma("unroll") for (int i = 0; i < 4; ++i) { const int c = tid + 512 * i; \
        pk[i] = *(const u32x4*)(kbase + (size_t)((kt) * 64 + (c >> 5)) * 4096 + (c & 31) * 8); \
        pv[i] = *(const u32x4*)(vbase + (size_t)(c >> 3) * M + (kt) * 64 + (c & 7) * 8); } } while (0)
#define RET_WRITE(bufp) do { _Pragma("unroll") for (int i = 0; i < 4; ++i) { const int c = tid + 512 * i; \
        *(LAS u32x4*)((bufp) + (c >> 5) * KST + (c & 31) * 16) = pk[i]; \
        *(LAS u32x4*)((bufp) + OFF_V + (c >> 3) * VST + (c & 7) * 16) = pv[i]; } } while (0)
    RET_PREFETCH(0);
    __syncthreads();
    RET_WRITE(lds);
    if (nkt > 1) RET_PREFETCH(1);
    for (int kt = 0; kt < nkt; ++kt) {
        __syncthreads();
        LAS unsigned char* cb = lds + (kt & 1) * BUF;
        if (kt + 1 < nkt) { LAS unsigned char* nb = lds + ((kt + 1) & 1) * BUF; RET_WRITE(nb); if (kt + 2 < nkt) RET_PREFETCH(kt + 2); }
        if (kt * 64 <= t0w + 15) {
            f32x4 sacc[4];
#pragma unroll
            for (int sb = 0; sb < 4; ++sb) sacc[sb] = (f32x4){0.f, 0.f, 0.f, 0.f};
#define RET_KF(dst, kk_) do { _Pragma("unroll") for (int sb = 0; sb < 4; ++sb) dst[sb] = *(const LAS bf16x8*)(cb + (16 * sb + r) * KST + (kk_) * 64 + q4 * 16); } while (0)
#define RET_VF(dst, eb_) do { _Pragma("unroll") for (int e2 = 0; e2 < 2; ++e2) _Pragma("unroll") for (int c = 0; c < 2; ++c) { const LAS unsigned char* vp = cb + OFF_V + (16 * ((eb_) + e2) + r) * VST + (32 * c + 4 * q4) * 2; \
                const s16x4 lo = *(const LAS s16x4*)vp, hi = *(const LAS s16x4*)(vp + 32); dst[e2][c] = __builtin_shufflevector(lo, hi, 0, 1, 2, 3, 4, 5, 6, 7); } } while (0)
            bf16x8 ka[4], kb[4], va[2][2], vb[2][2];
            RET_KF(ka, 0);
#pragma unroll
            for (int kk = 0; kk < 8; kk += 2) {
                RET_KF(kb, kk + 1); __builtin_amdgcn_sched_barrier(0);
{ __builtin_amdgcn_s_setprio(1);
#pragma unroll
for (int sb = 0; sb < 4; ++sb) sacc[sb] = MFMA16(ka[sb], qf[kk], sacc[sb]); __builtin_amdgcn_s_setprio(0); }
                __builtin_amdgcn_sched_barrier(0);
                if (kk + 2 < 8) RET_KF(ka, kk + 2); else RET_VF(va, 0);
                __builtin_amdgcn_sched_barrier(0);
{ __builtin_amdgcn_s_setprio(1);
#pragma unroll
for (int sb = 0; sb < 4; ++sb) sacc[sb] = MFMA16(kb[sb], qf[kk + 1], sacc[sb]); __builtin_amdgcn_s_setprio(0); }
                __builtin_amdgcn_sched_barrier(0);
            }
            const int dbase = t0w + r - (kt * 64 + 4 * q4);
#pragma unroll
            for (int sb = 0; sb < 4; ++sb)
#pragma unroll
                for (int i = 0; i < 4; ++i) { const int d = dbase - 16 * sb - i; const float w = __builtin_amdgcn_exp2f((float)d * lg); sacc[sb][i] = d >= 0 ? sacc[sb][i] * w : 0.f; }
            bf16x8 pf[2];
#pragma unroll
            for (int c = 0; c < 2; ++c) pf[c] = __builtin_bit_cast(bf16x8, pack8(sacc[2 * c], sacc[2 * c + 1]));
#pragma unroll
            for (int eb = 0; eb < 16; eb += 4) {
                RET_VF(vb, eb + 2); __builtin_amdgcn_sched_barrier(0); __builtin_amdgcn_s_setprio(1);
#pragma unroll
                for (int e2 = 0; e2 < 2; ++e2)
#pragma unroll
                    for (int c = 0; c < 2; ++c) o[eb + e2] = MFMA16(va[e2][c], pf[c], o[eb + e2]);
                __builtin_amdgcn_sched_barrier(0);
                __builtin_amdgcn_s_setprio(0); if (eb + 4 < 16) RET_VF(va, eb + 4);
                __builtin_amdgcn_sched_barrier(0); __builtin_amdgcn_s_setprio(1);
#pragma unroll
                for (int e2 = 0; e2 < 2; ++e2)
#pragma unroll
                    for (int c = 0; c < 2; ++c) o[eb + 2 + e2] = MFMA16(vb[e2][c], pf[c], o[eb + 2 + e2]);
                __builtin_amdgcn_s_setprio(0); __builtin_amdgcn_sched_barrier(0);
            }
#undef RET_KF
#undef RET_VF
        }
    }
#undef RET_PREFETCH
#undef RET_WRITE
    float ss = 0.f;
#pragma unroll
    for (int eb = 0; eb < 16; ++eb) ss += (o[eb][0] * o[eb][0] + o[eb][1] * o[eb][1]) + (o[eb][2] * o[eb][2] + o[eb][3] * o[eb][3]);
    ss += __shfl_xor(ss, 16); ss += __shfl_xor(ss, 32);
    const float rstd = __builtin_amdgcn_rsqf(ss * (1.f / 256.f) + EPS);
    const size_t row = (size_t)(R0 + wid * 16 + r);
    u32x2 gwv[16];
#pragma unroll
    for (int eb = 0; eb < 16; ++eb) gwv[eb] = *(const u32x2*)(Zn + row * 4096 + 2048 + h * 256 + 16 * eb + 4 * q4);
#pragma unroll
    for (int eb = 0; eb < 16; ++eb) { const int e = 16 * eb + 4 * q4;
        const u32x2 gw2 = gwv[eb];
        u32x2 w; w.x = pg8::cvt_pk_bf16(o[eb][0] * rstd * bf_lo(gw2.x), o[eb][1] * rstd * bf_hi(gw2.x)); w.y = pg8::cvt_pk_bf16(o[eb][2] * rstd * bf_lo(gw2.y), o[eb][3] * rstd * bf_hi(gw2.y));
        *(u32x2*)(Y + row * D + h * 256 + e) = w; }
}

__device__ __forceinline__ void sgu_unit(LAS unsigned char* lds, const bf16_t* Zn, const bf16_t* ZT, bf16_t* Y, const bf16_t* Wm  , const float* bias  , const float* gain  ,
                                         int b, int c, int g, int tid, int wid, int lane) {
    asm volatile("" : "+v"(tid), "+v"(lane));
    constexpr int WST = 272, VST = 272, OFF_W = 0, OFF_V = 128 * WST, OFF_P = OFF_V + 256 * VST, OFF_R = OFF_P + 8 * 64 * 8, OFF_GN = OFF_R + 512;
    const int r = lane & 15, q4 = lane >> 4;
    const int R0 = b * SEQ + c * 128;
    __syncthreads();
    { u32x4 sw_[4], sv_[8];
#pragma unroll
      for (int i = 0; i < 4; ++i) { const int ch = tid + 512 * i; sw_[i] = *(const u32x4*)(Wm + (size_t)g * 16384 + (ch >> 4) * 128 + (ch & 15) * 8); }
#pragma unroll
      for (int i = 0; i < 8; ++i) { const int ch = tid + 512 * i; sv_[i] = *(const u32x4*)(ZT + (size_t)(1024 + g * 256 + (ch >> 4)) * M + R0 + (ch & 15) * 8); }
      asm volatile("" :: "v"(sw_[0]), "v"(sw_[1]), "v"(sw_[2]), "v"(sw_[3]), "v"(sv_[0]), "v"(sv_[1]), "v"(sv_[2]), "v"(sv_[3]), "v"(sv_[4]), "v"(sv_[5]), "v"(sv_[6]), "v"(sv_[7]));
#pragma unroll
      for (int i = 0; i < 4; ++i) { const int ch = tid + 512 * i; *(LAS u32x4*)(lds + OFF_W + (ch >> 4) * WST + (ch & 15) * 16) = sw_[i]; }
#pragma unroll
      for (int i = 0; i < 8; ++i) { const int ch = tid + 512 * i; *(LAS u32x4*)(lds + OFF_V + (ch >> 4) * VST + (ch & 15) * 16) = sv_[i]; } }
    if (tid < 256) *(LAS float*)(lds + OFF_GN + tid * 4) = gain[g * 256 + tid];
    __syncthreads();
    { const int sp = tid & 63, part = tid >> 6; float a0 = 0.f, a1 = 0.f;
#pragma unroll 8
      for (int dd = 0; dd < 32; ++dd) { const unsigned w = *(const LAS unsigned*)(lds + OFF_V + (part * 32 + dd) * VST + sp * 4); const float v0 = bf_lo(w), v1 = bf_hi(w); a0 += v0 * v0; a1 += v1 * v1; }
      *(LAS f32x2*)(lds + OFF_P + (part * 64 + sp) * 8) = (f32x2){a0, a1}; }
    __syncthreads();
    if (tid < 64) { float a0 = 0.f, a1 = 0.f;
#pragma unroll
      for (int p = 0; p < 8; ++p) { const f32x2 v = *(const LAS f32x2*)(lds + OFF_P + (p * 64 + tid) * 8); a0 += v.x; a1 += v.y; }
      *(LAS f32x2*)(lds + OFF_R + tid * 8) = (f32x2){__builtin_amdgcn_rsqf(a0 * (1.f / 256.f) + EPS), __builtin_amdgcn_rsqf(a1 * (1.f / 256.f) + EPS)}; }
    __syncthreads();
    { const int sp = tid & 63, part = tid >> 6; const f32x2 rs = *(const LAS f32x2*)(lds + OFF_R + sp * 8);
#pragma unroll 8
      for (int dd = 0; dd < 32; ++dd) { const int d = part * 32 + dd; LAS unsigned* p = (LAS unsigned*)(lds + OFF_V + d * VST + sp * 4); const unsigned w = *p; const float gn = *(const LAS float*)(lds + OFF_GN + d * 4);
          *p = pg8::cvt_pk_bf16(bf_lo(w) * rs.x * gn, bf_hi(w) * rs.y * gn); } }
    __syncthreads();
    bf16x8 wf[4];
#pragma unroll
    for (int kk = 0; kk < 4; ++kk) wf[kk] = *(const LAS bf16x8*)(lds + OFF_W + (16 * wid + r) * WST + kk * 64 + q4 * 16);
    f32x4 acc[16];
#define SGU_VF(dst, db_) do { _Pragma("unroll") for (int kk = 0; kk < 4; ++kk) dst[kk] = *(const LAS bf16x8*)(lds + OFF_V + (16 * (db_) + r) * VST + kk * 64 + q4 * 16); } while (0)
    bf16x8 sva[4], svb[4];
    SGU_VF(sva, 0);
#pragma unroll
    for (int db = 0; db < 16; db += 2) {
        SGU_VF(svb, db + 1); __builtin_amdgcn_sched_barrier(0);
        acc[db] = (f32x4){0.f, 0.f, 0.f, 0.f};
#pragma unroll
        for (int kk = 0; kk < 4; ++kk) acc[db] = MFMA16(sva[kk], wf[kk], acc[db]);
        __builtin_amdgcn_sched_barrier(0);
        if (db + 2 < 16) SGU_VF(sva, db + 2);
        __builtin_amdgcn_sched_barrier(0);
        acc[db + 1] = (f32x4){0.f, 0.f, 0.f, 0.f};
#pragma unroll
        for (int kk = 0; kk < 4; ++kk) acc[db + 1] = MFMA16(svb[kk], wf[kk], acc[db + 1]);
        __builtin_amdgcn_sched_barrier(0);
    }
#undef SGU_VF
    const int t = 16 * wid + r; const float bs = bias[g * 128 + t];
    const size_t row = (size_t)(R0 + t);
    u32x2 uwv[16];
#pragma unroll
    for (int db = 0; db < 16; ++db) uwv[db] = *(const u32x2*)(Zn + row * 4096 + 3072 + g * 256 + 16 * db + 4 * q4);
#pragma unroll
    for (int db = 0; db < 16; ++db) { const int d = 16 * db + 4 * q4;
        const u32x2 uw = uwv[db];
        u32x2 w; w.x = pg8::cvt_pk_bf16((acc[db][0] + bs) * bf_lo(uw.x), (acc[db][1] + bs) * bf_hi(uw.x)); w.y = pg8::cvt_pk_bf16((acc[db][2] + bs) * bf_lo(uw.y), (acc[db][3] + bs) * bf_hi(uw.y));
        *(u32x2*)(Y + row * D + 1024 + g * 256 + d) = w; }
}

__device__ __forceinline__ void moba_tile(LAS unsigned char* lds, const bf16_t* Zn, const bf16_t* ZT, bf16_t* Y, const float* ksum, int b, int h, int qb, int tid, int wid, int lane) {
    asm volatile("" : "+v"(tid), "+v"(lane));
    constexpr int KST = 288, VST = 144, OFF_V = 64 * KST, BUF = OFF_V + 128 * VST, OFF_KS = 2 * BUF, OFF_G = OFF_KS + 4096, OFF_SEL = OFF_G + 8192;
    const int r = lane & 15, q4 = lane >> 4;
    const int R0 = b * SEQ + qb * 256, t0w = qb * 256 + wid * 32;
    const int nkt = 4 * (qb + 1);
    u32x4 pk[2], pv[2];
    const bf16_t* kbase = Zn + (size_t)(b * SEQ) * 3072 + 2048 + h * 128;
    const bf16_t* vbase = ZT + (size_t)(h * 128) * M + b * SEQ;
#define MOBA_PREFETCH(kt) do { _Pragma("unroll") for (int i = 0; i < 2; ++i) { const int c = tid + 512 * i; \
        pk[i] = *(const u32x4*)(kbase + (size_t)((kt) * 64 + (c >> 4)) * 3072 + (c & 15) * 8); \
        pv[i] = *(const u32x4*)(vbase + (size_t)(c >> 3) * M + (kt) * 64 + (c & 7) * 8); } } while (0)
#define MOBA_WRITE(bufp) do { _Pragma("unroll") for (int i = 0; i < 2; ++i) { const int c = tid + 512 * i; \
        *(LAS u32x4*)((bufp) + (c >> 4) * KST + (c & 15) * 16) = pk[i]; \
        *(LAS u32x4*)((bufp) + OFF_V + (c >> 3) * VST + (c & 7) * 16) = pv[i]; } } while (0)
    MOBA_PREFETCH(0);
    __syncthreads();
    unsigned mysel[2] = {(1u << qb) - 1u, (1u << qb) - 1u};
    if (qb >= 4) {
#pragma unroll
        for (int i = 0; i < 2; ++i) { const int e = tid + 512 * i; *(LAS float*)(lds + OFF_KS + e * 4) = ksum[(size_t)(b * 8 + (e >> 7)) * 1024 + h * 128 + (e & 127)]; }
        __syncthreads();
        { const int t = tid & 255, part = tid >> 8; const bf16_t* qrow = Zn + (size_t)(R0 + t) * 3072 + 1024 + h * 128;
          float g[4] = {0.f, 0.f, 0.f, 0.f};
          u32x4 qw_[16];
#pragma unroll
          for (int c = 0; c < 16; ++c) qw_[c] = *(const u32x4*)(qrow + 8 * c);
#pragma unroll
          for (int c = 0; c < 16; ++c) { const u32x4 w = qw_[c];
              const f32x4 ql = (f32x4){bf_lo(w.x), bf_hi(w.x), bf_lo(w.y), bf_hi(w.y)}, qh = (f32x4){bf_lo(w.z), bf_hi(w.z), bf_lo(w.w), bf_hi(w.w)};
#pragma unroll
              for (int i = 0; i < 4; ++i) { const LAS f32x4* kp = (const LAS f32x4*)(lds + OFF_KS + ((part + 2 * i) * 128 + 8 * c) * 4);
                  const f32x4 p = ql * kp[0] + qh * kp[1]; g[i] += (p[0] + p[1]) + (p[2] + p[3]); } }
#pragma unroll
          for (int i = 0; i < 4; ++i) *(LAS float*)(lds + OFF_G + (t * 8 + part + 2 * i) * 4) = g[i]; }
        __syncthreads();
        if (tid < 256) { float gv[8];
#pragma unroll
            for (int n = 0; n < 8; ++n) gv[n] = *(const LAS float*)(lds + OFF_G + (tid * 8 + n) * 4);
            unsigned bits = 0u;
#pragma unroll
            for (int n = 0; n < 8; ++n) { int rank = 0;
#pragma unroll
                for (int m2 = 0; m2 < 8; ++m2) rank += (m2 < qb && m2 != n && (gv[m2] > gv[n] || (gv[m2] == gv[n] && m2 < n))) ? 1 : 0;
                if (n < qb && rank < 3) bits |= 1u << n; }
            *(LAS unsigned*)(lds + OFF_SEL + tid * 4) = bits; }
        __syncthreads();
#pragma unroll
        for (int tb = 0; tb < 2; ++tb) mysel[tb] = *(const LAS unsigned*)(lds + OFF_SEL + (wid * 32 + 16 * tb + r) * 4);
    }
    MOBA_WRITE(lds);
    if (nkt > 1) MOBA_PREFETCH(1);
    bf16x8 qf[2][4];
#pragma unroll
    for (int tb = 0; tb < 2; ++tb) { const bf16_t* qrow = Zn + (size_t)(R0 + wid * 32 + 16 * tb + r) * 3072 + 1024 + h * 128 + q4 * 8;
#pragma unroll
      for (int kk = 0; kk < 4; ++kk) qf[tb][kk] = *(const bf16x8*)(qrow + kk * 32); }
    f32x4 o[2][8];
#pragma unroll
    for (int tb = 0; tb < 2; ++tb)
#pragma unroll
        for (int e = 0; e < 8; ++e) o[tb][e] = (f32x4){0.f, 0.f, 0.f, 0.f};
    float m_run[2] = {-1e30f, -1e30f}, l_run[2] = {0.f, 0.f};
    for (int kt = 0; kt < nkt; ++kt) {
        __syncthreads();
        LAS unsigned char* cb = lds + (kt & 1) * BUF;
        if (kt + 1 < nkt) { LAS unsigned char* nb = lds + ((kt + 1) & 1) * BUF; MOBA_WRITE(nb); if (kt + 2 < nkt) MOBA_PREFETCH(kt + 2); }
        const int nblk = kt >> 2; const bool own = (nblk == qb);
        if (!own || kt * 64 <= t0w + 31) {
            f32x4 sacc[2][4];
#pragma unroll
            for (int tb = 0; tb < 2; ++tb)
#pragma unroll
                for (int sb = 0; sb < 4; ++sb) sacc[tb][sb] = (f32x4){0.f, 0.f, 0.f, 0.f};
#define MOBA_KF(dst, kk_) do { _Pragma("unroll") for (int sb = 0; sb < 4; ++sb) dst[sb] = *(const LAS bf16x8*)(cb + (16 * sb + r) * KST + (kk_) * 64 + q4 * 16); } while (0)
#define MOBA_VF(dst, eb_) do { _Pragma("unroll") for (int e2 = 0; e2 < 2; ++e2) _Pragma("unroll") for (int c = 0; c < 2; ++c) { const LAS unsigned char* vp = cb + OFF_V + (16 * ((eb_) + e2) + r) * VST + (32 * c + 4 * q4) * 2; \
                const s16x4 lo = *(const LAS s16x4*)vp, hi = *(const LAS s16x4*)(vp + 32); dst[e2][c] = __builtin_shufflevector(lo, hi, 0, 1, 2, 3, 4, 5, 6, 7); } } while (0)
            bf16x8 ka[4], kb[4], va[2][2], vb[2][2];
            MOBA_KF(ka, 0);
#pragma unroll
            for (int kk = 0; kk < 4; kk += 2) {
                MOBA_KF(kb, kk + 1); __builtin_amdgcn_sched_barrier(0); __builtin_amdgcn_s_setprio(1);
#pragma unroll
                for (int sb = 0; sb < 4; ++sb) { sacc[0][sb] = MFMA16(ka[sb], qf[0][kk], sacc[0][sb]); sacc[1][sb] = MFMA16(ka[sb], qf[1][kk], sacc[1][sb]); }
                __builtin_amdgcn_s_setprio(0); __builtin_amdgcn_sched_barrier(0);
                if (kk + 2 < 4) MOBA_KF(ka, kk + 2); else MOBA_VF(va, 0);
                __builtin_amdgcn_sched_barrier(0); __builtin_amdgcn_s_setprio(1);
#pragma unroll
                for (int sb = 0; sb < 4; ++sb) { sacc[0][sb] = MFMA16(kb[sb], qf[0][kk + 1], sacc[0][sb]); sacc[1][sb] = MFMA16(kb[sb], qf[1][kk + 1], sacc[1][sb]); }
                __builtin_amdgcn_s_setprio(0); __builtin_amdgcn_sched_barrier(0);
            }
            bf16x8 pf[2][2];
#pragma unroll
            for (int tb = 0; tb < 2; ++tb) {
                const int t0b = t0w + 16 * tb;
                float mx = -1e30f;
                const bool diag = own && (kt * 64 + 63 > t0b);
                bool rowok = true;
                if (diag) { const int dbase = t0b + r - (kt * 64 + 4 * q4);
#pragma unroll
                    for (int sb = 0; sb < 4; ++sb)
#pragma unroll
                        for (int i = 0; i < 4; ++i) { sacc[tb][sb][i] = (dbase - 16 * sb - i >= 0) ? sacc[tb][sb][i] : -1e30f; mx = fmaxf(mx, sacc[tb][sb][i]); }
                } else { rowok = own || (((mysel[tb] >> nblk) & 1u) != 0u);
#pragma unroll
                    for (int sb = 0; sb < 4; ++sb) mx = fmaxf(fmaxf(mx, fmaxf(sacc[tb][sb][0], sacc[tb][sb][1])), fmaxf(sacc[tb][sb][2], sacc[tb][sb][3]));
                    mx = rowok ? mx : -1e30f; }
                mx = fmaxf(mx, __shfl_xor(mx, 16)); mx = fmaxf(mx, __shfl_xor(mx, 32));
                const float m_new = fmaxf(m_run[tb], mx);
                const float alpha = __builtin_amdgcn_exp2f(m_run[tb] - m_new);
                float ps = 0.f;
                if (diag) {
#pragma unroll
                    for (int sb = 0; sb < 4; ++sb)
#pragma unroll
                        for (int i = 0; i < 4; ++i) { const float p = sacc[tb][sb][i] > -1e29f ? __builtin_amdgcn_exp2f(sacc[tb][sb][i] - m_new) : 0.f; sacc[tb][sb][i] = p; ps += p; }
                } else { const float mm = rowok ? m_new : 1e30f;
#pragma unroll
                    for (int sb = 0; sb < 4; ++sb)
#pragma unroll
                        for (int i = 0; i < 4; ++i) { const float p = __builtin_amdgcn_exp2f(sacc[tb][sb][i] - mm); sacc[tb][sb][i] = p; ps += p; } }
                l_run[tb] = l_run[tb] * alpha + ps; m_run[tb] = m_new;
#pragma unroll
                for (int e = 0; e < 8; ++e) o[tb][e] = o[tb][e] * alpha;
#pragma unroll
                for (int c = 0; c < 2; ++c) pf[tb][c] = __builtin_bit_cast(bf16x8, pack8(sacc[tb][2 * c], sacc[tb][2 * c + 1]));
            }
#pragma unroll
            for (int eb = 0; eb < 8; eb += 4) {
                MOBA_VF(vb, eb + 2); __builtin_amdgcn_sched_barrier(0); __builtin_amdgcn_s_setprio(1);
#pragma unroll
                for (int e2 = 0; e2 < 2; ++e2)
#pragma unroll
                    for (int c = 0; c < 2; ++c) { o[0][eb + e2] = MFMA16(va[e2][c], pf[0][c], o[0][eb + e2]); o[1][eb + e2] = MFMA16(va[e2][c], pf[1][c], o[1][eb + e2]); }
                __builtin_amdgcn_s_setprio(0); if (eb + 4 < 8) MOBA_VF(va, eb + 4);
                __builtin_amdgcn_sched_barrier(0); __builtin_amdgcn_s_setprio(1);
#pragma unroll
                for (int e2 = 0; e2 < 2; ++e2)
#pragma unroll
                    for (int c = 0; c < 2; ++c) { o[0][eb + 2 + e2] = MFMA16(vb[e2][c], pf[0][c], o[0][eb + 2 + e2]); o[1][eb + 2 + e2] = MFMA16(vb[e2][c], pf[1][c], o[1][eb + 2 + e2]); }
                __builtin_amdgcn_s_setprio(0); __builtin_amdgcn_sched_barrier(0);
            }
#undef MOBA_KF
#undef MOBA_VF
        }
    }
#undef MOBA_PREFETCH
#undef MOBA_WRITE
#pragma unroll
    for (int tb = 0; tb < 2; ++tb) {
        float l = l_run[tb]; l += __shfl_xor(l, 16); l += __shfl_xor(l, 32);
        const float inv = 1.0f / l;
        const size_t row = (size_t)(R0 + wid * 32 + 16 * tb + r);
#pragma unroll
        for (int eb = 0; eb < 8; ++eb) { const int e = 16 * eb + 4 * q4;
            u32x2 w; w.x = pg8::cvt_pk_bf16(o[tb][eb][0] * inv, o[tb][eb][1] * inv); w.y = pg8::cvt_pk_bf16(o[tb][eb][2] * inv, o[tb][eb][3] * inv);
            *(u32x2*)(Y + row * D + 1024 + h * 128 + e) = w; } }
}

__device__ __forceinline__ void pool_unit(LAS unsigned char* lds, const bf16_t* Zn, bf16_t* Y, const bf16_t* Wt  , const float* scale  , int rt, int gi, int tid, int wid, int lane) {
    asm volatile("" : "+v"(tid), "+v"(lane));
    constexpr int AST = 544;
    const int r = lane & 15, q4 = lane >> 4;
    const int R0 = rt * 128, p0 = R0 & (SEQ - 1), win = 2 << gi;
    __syncthreads();
    { const int cc = tid & 31, tg = tid >> 5;
      const bf16_t* zb = Zn + (size_t)R0 * 3072 + gi * 256 + cc * 8;
      const int tfirst = tg * 8;
      u32x4 zr[23];
#pragma unroll
      for (int k = 0; k < 23; ++k) { int tt = tfirst - 15 + k; tt = (p0 + tt >= 0) ? tt : -p0; zr[k] = *(const u32x4*)(zb + (ptrdiff_t)tt * 3072); }
#pragma unroll
      for (int j8 = 0; j8 < 8; ++j8) { const int pos = p0 + tfirst + j8;
          f32x4 s0 = (f32x4){0.f, 0.f, 0.f, 0.f}, s1 = (f32x4){0.f, 0.f, 0.f, 0.f};
#pragma unroll
          for (int dt = 0; dt < 16; ++dt) { const u32x4 w = zr[15 + j8 - dt]; const float m = (dt < win && pos - dt >= 0) ? 1.f : 0.f;
              s0 += (f32x4){bf_lo(w.x), bf_hi(w.x), bf_lo(w.y), bf_hi(w.y)} * m; s1 += (f32x4){bf_lo(w.z), bf_hi(w.z), bf_lo(w.w), bf_hi(w.w)} * m; }
          const u32x4 w = zr[15 + j8]; const float ic = __builtin_amdgcn_rcpf((float)(pos + 1 < win ? pos + 1 : win));
          const f32x4 a = s0 * ic - (f32x4){bf_lo(w.x), bf_hi(w.x), bf_lo(w.y), bf_hi(w.y)}, bq = s1 * ic - (f32x4){bf_lo(w.z), bf_hi(w.z), bf_lo(w.w), bf_hi(w.w)};
          *(LAS u32x4*)(lds + (tfirst + j8) * AST + cc * 16) = pack8(a, bq); } }
    bf16x8 wf[2][8];
    { const bf16_t* wb = Wt + (size_t)gi * 65536 + (size_t)(32 * wid + r) * 256 + q4 * 8;
#pragma unroll
      for (int nbi = 0; nbi < 2; ++nbi)
#pragma unroll
          for (int kk = 0; kk < 8; ++kk) wf[nbi][kk] = *(const bf16x8*)(wb + (size_t)nbi * 16 * 256 + kk * 32); }
    __syncthreads();
    f32x4 sc[2];
#pragma unroll
    for (int nbi = 0; nbi < 2; ++nbi) sc[nbi] = *(const f32x4*)(scale + gi * 256 + 32 * wid + 16 * nbi + 4 * q4);
#define POOL_AF(dst, tb_) do { _Pragma("unroll") for (int kk = 0; kk < 8; ++kk) dst[kk] = *(const LAS bf16x8*)(lds + (16 * (tb_) + r) * AST + kk * 64 + q4 * 16); } while (0)
    bf16x8 afa[8], afb[8];
    POOL_AF(afa, 0);
#pragma unroll
    for (int tb = 0; tb < 8; ++tb) { f32x4 acc[2] = {(f32x4){0.f, 0.f, 0.f, 0.f}, (f32x4){0.f, 0.f, 0.f, 0.f}};
        if (tb + 1 < 8) { if (tb & 1) POOL_AF(afa, tb + 1); else POOL_AF(afb, tb + 1); }
        __builtin_amdgcn_sched_barrier(0);
#pragma unroll
        for (int kk = 0; kk < 8; ++kk) { const bf16x8 af = (tb & 1) ? afb[kk] : afa[kk];
            acc[0] = MFMA16(wf[0][kk], af, acc[0]); acc[1] = MFMA16(wf[1][kk], af, acc[1]); }
        __builtin_amdgcn_sched_barrier(0);
        const size_t row = (size_t)(R0 + 16 * tb + r);
#pragma unroll
        for (int nbi = 0; nbi < 2; ++nbi) { const int n = 32 * wid + 16 * nbi + 4 * q4;
            u32x2 w; w.x = pg8::cvt_pk_bf16(acc[nbi][0] * sc[nbi][0], acc[nbi][1] * sc[nbi][1]); w.y = pg8::cvt_pk_bf16(acc[nbi][2] * sc[nbi][2], acc[nbi][3] * sc[nbi][3]);
            *(u32x2*)(Y + row * D + gi * 256 + n) = w; } }
#undef POOL_AF
}

constexpr int NPH = 1 + 12 * DEPTH;
struct Args { const float* in[17]; float* out; unsigned char* ws; int ph_lo, ph_hi; };
typedef const __attribute__((address_space(4))) Args* ArgP;
__device__ __forceinline__ ArgP argp() { ArgP p = (ArgP)__builtin_amdgcn_kernarg_segment_ptr(); asm volatile("" : "+s"(p)); return p; }
#define PHASE_LOCALS() ArgP ap = argp(); unsigned char* const ws = ap->ws; int tid = threadIdx.x; asm volatile("" : "+v"(tid)); \
    int G_ = gridDim.x, bx_ = blockIdx.x; asm volatile("" : "+s"(G_), "+s"(bx_)); \
    const int lane = tid & 63, wid = __builtin_amdgcn_readfirstlane(tid >> 6), G = G_, bx = bx_, vcu = (G % 8 == 0) ? (bx % 8) * (G / 8) + bx / 8 : bx, gw = vcu * 8 + wid, NGW = G * 8; \
    (void)lane; (void)gw; (void)NGW; (void)ws
__global__ void __launch_bounds__(512, 2) mega_fwd(Args args_unused) {
    extern __shared__ __attribute__((aligned(16))) unsigned char lds_raw[];
    LAS unsigned char* lds = (LAS unsigned char*)lds_raw;
    volatile LAS unsigned* MISC = (volatile LAS unsigned*)(lds + MISC_OFF);
    for (int u = threadIdx.x; u < (LDS_BYTES - RING_BYTES) / 4; u += 512) ((LAS unsigned*)(lds + RING_BYTES))[u] = 0u;
    __syncthreads();
    int lo, hi; XcdBarrier bar;
    { ArgP ap = argp(); lo = ap->ph_lo; hi = ap->ph_hi; unsigned* ctl = (unsigned*)(ap->ws + WS_CTL);
      bar.bar = ctl + CW_BAR; bar.x = 0; bar.st = nullptr;
      if (hi - lo > 1) bar = xcd_barrier_post(ctl + CW_BAR, MISC + 8); }
#define IN(k) (lo <= (k) && (k) < hi)
#define SEAM(k) do { if (IN(k) && IN((k) + 1)) xcd_barrier(bar); } while (0)
#define P_T   ((bf16_t*)(ws + WS_T))
#define P_Y   ((bf16_t*)(ws + WS_Y))
#define P_BIG ((bf16_t*)(ws + WS_BIG))
#define P_ZT  ((bf16_t*)(ws + WS_BIG + 256 * MiB))
#define P_XB  ((bf16_t*)(ws + WS_H))
#define P_RS  ((float*)(ws + WS_RS))
#define P_X8  ((unsigned char*)(ws + WS_X8))

    if (IN(0)) {
        PHASE_LOCALS();
        LAS float* scr = (LAS float*)(lds + wid * 16384);
        for (int L = 0; L < DEPTH; ++L) {
            const int j = L >> 1;
            for (int f = 0; f < 2; ++f) {
                bf16_t* wgu = (bf16_t*)(ws + WS_WGU + (size_t)(L * 2 + f) * SZ_WGU);
                if (gu_f8(L, f)) { xpose_matrix_f8(ap->in[3] + (size_t)(L * 2 + f) * D * FF, D, FF, (unsigned char*)wgu, F8_WGSCALE, scr, gw, NGW, lane, 1, ap->in[2] + (size_t)(L * 8 + 4 * f) * D);
                                   xpose_matrix_f8(ap->in[4] + (size_t)(L * 2 + f) * D * FF, D, FF, (unsigned char*)wgu, F8_WGSCALE, scr, gw, NGW, lane, 2, ap->in[2] + (size_t)(L * 8 + 4 * f) * D); }
                else { xpose_matrix(ap->in[3] + (size_t)(L * 2 + f) * D * FF, D, FF, wgu, 1, scr, gw, NGW, lane, ap->in[2] + (size_t)(L * 8 + 4 * f) * D);
                       xpose_matrix(ap->in[4] + (size_t)(L * 2 + f) * D * FF, D, FF, wgu, 2, scr, gw, NGW, lane, ap->in[2] + (size_t)(L * 8 + 4 * f) * D); }
                if (dn_f8(L, f)) xpose_matrix_f8(ap->in[5] + (size_t)(L * 2 + f) * FF * D, FF, D, ws + WS_WDN + (size_t)(L * 2 + f) * SZ_WDN, F8_WSCALE, scr, gw, NGW, lane);
                else xpose_matrix(ap->in[5] + (size_t)(L * 2 + f) * FF * D, FF, D, (bf16_t*)(ws + WS_WDN + (size_t)(L * 2 + f) * SZ_WDN), 0, scr, gw, NGW, lane);
            }
            if ((L & 1) == 0) {
                xpose_matrix(ap->in[6] + (size_t)j * D * 6144, D, 6144, (bf16_t*)(ws + WS_WINE + (size_t)j * 6144 * D * 2), 3, scr, gw, NGW, lane, ap->in[2] + (size_t)(L * 8 + 2) * D);
                xpose_matrix(ap->in[7] + (size_t)j * D * D, D, D, (bf16_t*)(ws + WS_WOUT + (size_t)L * D * D * 2), 0, scr, gw, NGW, lane);
            } else {
                xpose_matrix(ap->in[11] + (size_t)j * D * 4096, D, 4096, (bf16_t*)(ws + WS_WINO + (size_t)j * 4096 * D * 2), 0, scr, gw, NGW, lane, ap->in[2] + (size_t)(L * 8 + 2) * D);
                xpose_matrix(ap->in[12] + (size_t)j * D * D, D, D, (bf16_t*)(ws + WS_WOUT + (size_t)L * D * D * 2), 0, scr, gw, NGW, lane);
                for (int g = 0; g < 4; ++g) xpose_matrix(ap->in[13] + (size_t)(j * 4 + g) * 65536, 256, 256, (bf16_t*)(ws + WS_POOLW) + (size_t)(j * 4 + g) * 65536, 0, scr, gw, NGW, lane);
            }
            xpose_matrix(ap->in[15] + (size_t)L * D * D, D, D, (bf16_t*)(ws + WS_WPG + (size_t)L * D * D * 2), 0, scr, gw, NGW, lane, ap->in[2] + (size_t)(L * 8 + 6) * D);
            xpose_matrix(ap->in[16] + (size_t)L * PLE * D, PLE, D, (bf16_t*)(ws + WS_WPP + (size_t)L * D * PLE * 2), 0, scr, gw, NGW, lane);
        }
        { const float* p_in = ap->in[1]; bf16_t* pb = (bf16_t*)(ws + WS_PBF); const size_t n8 = (size_t)DEPTH * M * PLE / 8;
          for (size_t i = (size_t)gw * 64 + lane; i < n8; i += (size_t)NGW * 64) { const f32x4 a = *(const f32x4*)(p_in + i * 8), b2 = *(const f32x4*)(p_in + i * 8 + 4); *(u32x4*)(pb + i * 8) = pack8(a, b2); } }
        { float* rc = (float*)(ws + WS_RCOS); float* rs = (float*)(ws + WS_RSIN); float* mc = (float*)(ws + WS_MCOS); float* ms = (float*)(ws + WS_MSIN);
          const int gt = gw * 64 + lane, NT = NGW * 64;
          for (int i = gt; i < SEQ * 128; i += NT) { const int t = i >> 7, f = i & 127; const float inv = 1.0f / powf(10000.0f, (float)f / 128.0f); const float ang = (float)t * inv;
              double rv = (double)ang * 0.15915494309189535; rv -= __builtin_rint(rv); rc[i] = __builtin_amdgcn_cosf((float)rv); rs[i] = __builtin_amdgcn_sinf((float)rv); }
          for (int i = gt; i < SEQ * 16; i += NT) { const int t = i >> 4, f = i & 15; const float inv = 1.0f / powf(500000.0f, (float)f / 16.0f); const float ang = (float)t * inv;
              double rv = (double)ang * 0.15915494309189535; rv -= __builtin_rint(rv); mc[i] = __builtin_amdgcn_cosf((float)rv); ms[i] = __builtin_amdgcn_sinf((float)rv); }
          const float* sgw = ap->in[8]; bf16_t* sw = (bf16_t*)(ws + WS_SGUW);
          for (int i = gt; i < 2 * 4 * 128 * 128; i += NT) { const int s = i & 127, t = (i >> 7) & 127; sw[i] = (bf16_t)f2bf(s <= t ? sgw[i] : 0.f); } }
        rphase<false, true, false>(ap->in[0], P_XB, nullptr, 0.f, nullptr, P_RS, gw, NGW, lane, gu_f8(0, 0) ? P_X8 : nullptr);
    }
    SEAM(0);

    for (int L = 0; L < DEPTH; ++L) {
        const int pb = 1 + 12 * L;
        if (IN(pb + 0)) { PHASE_LOCALS(); pg8::Gemm g{P_XB, (const bf16_t*)(ws + WS_WGU + (size_t)(L * 2) * SZ_WGU), M, 2 * FF, D}; pg8::StaticOrder S; S.init(M, 2 * FF, G, bx); if (gu_f8(L, 0)) { pg8::Gemm g8{(const bf16_t*)P_X8, g.Bt, M, 2 * FF, D / 2}; EpiGU8 E{(unsigned char*)P_BIG, P_RS, 1.f / (F8_XSCALE * F8_WGSCALE)}; pg8::gemm_phase<EpiGU8, pg8::StaticOrder, true, true, true>(lds, g8, S, E); }
            else if (dn_f8(L, 0)) { EpiGU8 E{(unsigned char*)P_BIG, P_RS, 1.f}; pg8::gemm_phase<EpiGU8, pg8::StaticOrder, true, true>(lds, g, S, E); }
            else { EpiGU E{P_BIG, P_RS}; pg8::gemm_phase<EpiGU, pg8::StaticOrder, true, true>(lds, g, S, E); } }
        SEAM(pb + 0);
        if (IN(pb + 1)) { PHASE_LOCALS(); pg8::StaticOrder S; S.init(M, D, G, bx);
            if (dn_f8(L, 0)) { pg8::Gemm g{P_BIG, (const bf16_t*)(ws + WS_WDN + (size_t)(L * 2) * SZ_WDN), M, D, FF / 2}; EpiPlainS E{P_T, D, 1.f / (F8_ASCALE * F8_WSCALE)};
                pg8::gemm_phase<EpiPlainS, pg8::StaticOrder, true, true, true>(lds, g, S, E); }
            else { pg8::Gemm g{P_BIG, (const bf16_t*)(ws + WS_WDN + (size_t)(L * 2) * SZ_WDN), M, D, FF}; EpiPlain E{P_T, D, 1 << 30};
                pg8::gemm_phase<EpiPlain, pg8::StaticOrder, true, true>(lds, g, S, E); } }
        SEAM(pb + 1);
        if (IN(pb + 2)) { PHASE_LOCALS(); const float* ng = ap->in[2] + (size_t)L * 8 * D; rphase<true, false, false>(P_XB, P_XB, P_T, 0.5f, ng + 1 * D, P_RS, gw, NGW, lane); }
        SEAM(pb + 2);
        if (IN(pb + 3)) {
            PHASE_LOCALS(); const int j = L >> 1;
            if ((L & 1) == 0) { const bf16_t* Win = (const bf16_t*)(ws + WS_WINE + (size_t)j * 6144 * D * 2);
                { pg8::Gemm g{P_XB, Win, M, 4096, D}; pg8::StaticOrder S; S.init(M, 4096, G, bx); EpiInEven E{P_BIG, (const float*)(ws + WS_RCOS), (const float*)(ws + WS_RSIN), P_RS};
                  pg8::gemm_phase<EpiInEven, pg8::StaticOrder, true, true>(lds, g, S, E); }
                { pg8::Gemm g{Win + (size_t)4096 * D, P_XB, 2048, M, D}; pg8::StaticOrder S; S.init(2048, M, G, bx); EpiPlainT E{P_ZT, M, 4, P_RS};
                  pg8::gemm_phase<EpiPlainT, pg8::StaticOrder, true, true>(lds, g, S, E); }
            } else { const bf16_t* Win = (const bf16_t*)(ws + WS_WINO + (size_t)j * 4096 * D * 2);
                { pg8::Gemm g{P_XB, Win, M, 3072, D}; pg8::StaticOrder S; S.init(M, 3072, G, bx); EpiInOdd E{P_BIG, (const float*)(ws + WS_MCOS), (const float*)(ws + WS_MSIN), (float*)(ws + WS_KSUM) + (size_t)j * 128 * 1024, P_RS};
                  pg8::gemm_phase<EpiInOdd, pg8::StaticOrder, true, true>(lds, g, S, E); }
                { pg8::Gemm g{Win + (size_t)3072 * D, P_XB, 1024, M, D}; pg8::StaticOrder S; S.init(1024, M, G, bx); EpiPlainT E{P_ZT, M, 1 << 30, P_RS};
                  pg8::gemm_phase<EpiPlainT, pg8::StaticOrder, true, true>(lds, g, S, E); }
            }
        }
        SEAM(pb + 3);
        if (IN(pb + 4)) {
            PHASE_LOCALS(); const int j = L >> 1;
            if ((L & 1) == 0) {
                const bf16_t* sw = (const bf16_t*)(ws + WS_SGUW) + (size_t)j * 4 * 16384;
                for (int u = bx; u < 512 + 1024; u += G) {
                    if (u < 512) { const int uix = ((u >> 3) & 31) + 32 * (u >> 8), bh = 8 * (u & 7) + (uix >> 3), pr = uix & 7;
                        ret_tile(lds, P_BIG, P_ZT, P_Y, bh >> 2, bh & 3, 15 - pr, tid, wid, lane);
                        ret_tile(lds, P_BIG, P_ZT, P_Y, bh >> 2, bh & 3, pr, tid, wid, lane);
                    } else { const int v = u - 512; sgu_unit(lds, P_BIG, P_ZT, P_Y, sw, ap->in[9] + (size_t)j * 512, ap->in[10] + (size_t)j * 1024, v >> 6, (v >> 2) & 15, v & 3, tid, wid, lane); }
                }
            } else {
                const float* ks = (const float*)(ws + WS_KSUM) + (size_t)j * 128 * 1024;
                const bf16_t* pw = (const bf16_t*)(ws + WS_POOLW) + (size_t)j * 4 * 65536;
                for (int u = bx; u < 512 + 1024; u += G) {
                    if (u < 512) { const int uix = ((u >> 3) & 31) + 32 * (u >> 8), bh = 16 * (u & 7) + (uix >> 2), pr = uix & 3;
                        moba_tile(lds, P_BIG, P_ZT, P_Y, ks, bh >> 3, bh & 7, 7 - pr, tid, wid, lane);
                        moba_tile(lds, P_BIG, P_ZT, P_Y, ks, bh >> 3, bh & 7, pr, tid, wid, lane);
                    } else { const int v = u - 512; pool_unit(lds, P_BIG, P_Y, pw, ap->in[14] + (size_t)j * 1024, v >> 2, v & 3, tid, wid, lane); }
                }
            }
        }
        SEAM(pb + 4);
        if (IN(pb + 5)) { PHASE_LOCALS(); pg8::Gemm g{P_Y, (const bf16_t*)(ws + WS_WOUT + (size_t)L * D * D * 2), M, D, D}; pg8::StaticOrder S; S.init(M, D, G, bx); EpiPlain E{P_T, D, 1 << 30};
            pg8::gemm_phase<EpiPlain, pg8::StaticOrder, true, true>(lds, g, S, E); }
        SEAM(pb + 5);
        if (IN(pb + 6)) { PHASE_LOCALS(); const float* ng = ap->in[2] + (size_t)L * 8 * D; rphase<true, false, false>(P_XB, P_XB, P_T, 1.0f, ng + 3 * D, P_RS, gw, NGW, lane, gu_f8(L, 1) ? P_X8 : nullptr); }
        SEAM(pb + 6);
        if (IN(pb + 7)) { PHASE_LOCALS(); pg8::Gemm g{P_XB, (const bf16_t*)(ws + WS_WGU + (size_t)(L * 2 + 1) * SZ_WGU), M, 2 * FF, D}; pg8::StaticOrder S; S.init(M, 2 * FF, G, bx); if (gu_f8(L, 1)) { pg8::Gemm g8{(const bf16_t*)P_X8, g.Bt, M, 2 * FF, D / 2}; EpiGU8 E{(unsigned char*)P_BIG, P_RS, 1.f / (F8_XSCALE * F8_WGSCALE)}; pg8::gemm_phase<EpiGU8, pg8::StaticOrder, true, true, true>(lds, g8, S, E); }
            else if (dn_f8(L, 1)) { EpiGU8 E{(unsigned char*)P_BIG, P_RS, 1.f}; pg8::gemm_phase<EpiGU8, pg8::StaticOrder, true, true>(lds, g, S, E); }
            else { EpiGU E{P_BIG, P_RS}; pg8::gemm_phase<EpiGU, pg8::StaticOrder, true, true>(lds, g, S, E); } }
        SEAM(pb + 7);
        if (IN(pb + 8)) {
            PHASE_LOCALS();
            if (dn_f8(L, 1)) { pg8::Gemm g{P_BIG, (const bf16_t*)(ws + WS_WDN + (size_t)(L * 2 + 1) * SZ_WDN), M, D, FF / 2}; pg8::StaticOrder S; S.init(M, D, G, bx); EpiPlainS E{P_T, D, 1.f / (F8_ASCALE * F8_WSCALE)};
              pg8::gemm_phase<EpiPlainS, pg8::StaticOrder, true, true, true>(lds, g, S, E); }
            else { pg8::Gemm g{P_BIG, (const bf16_t*)(ws + WS_WDN + (size_t)(L * 2 + 1) * SZ_WDN), M, D, FF}; pg8::StaticOrder S; S.init(M, D, G, bx); EpiPlain E{P_T, D, 1 << 30};
              pg8::gemm_phase<EpiPlain, pg8::StaticOrder, true, true>(lds, g, S, E); }
            { pg8::Gemm g{(const bf16_t*)(ws + WS_PBF) + (size_t)L * M * PLE, (const bf16_t*)(ws + WS_WPP + (size_t)L * D * PLE * 2), M, D, PLE}; pg8::StaticOrder S; S.init(M, D, G, bx); EpiPlain E{P_Y, D, 1 << 30};
              pg8::gemm_phase<EpiPlain, pg8::StaticOrder, true, true>(lds, g, S, E); }
        }
        SEAM(pb + 8);
        if (IN(pb + 9)) { PHASE_LOCALS(); const float* ng = ap->in[2] + (size_t)L * 8 * D; rphase<true, false, false>(P_XB, P_XB, P_T, 0.5f, ng + 5 * D, P_RS, gw, NGW, lane); }
        SEAM(pb + 9);
        if (IN(pb + 10)) { PHASE_LOCALS(); pg8::Gemm g{P_XB, (const bf16_t*)(ws + WS_WPG + (size_t)L * D * D * 2), M, D, D}; pg8::StaticOrder S; S.init(M, D, G, bx); EpiPleGate E{P_T, P_Y, P_RS};
            pg8::gemm_phase<EpiPleGate, pg8::StaticOrder, true, true>(lds, g, S, E); }
        SEAM(pb + 10);
        if (IN(pb + 11)) { PHASE_LOCALS(); const float* ng = ap->in[2] + (size_t)L * 8 * D; if (L + 1 < DEPTH) rphase<true, false, false>(P_XB, P_XB, P_T, 1.0f, ng + 7 * D, P_RS, gw, NGW, lane, gu_f8(L + 1, 0) ? P_X8 : nullptr);
            else rphase<true, false, true>(P_XB, ap->out, P_T, 1.0f, ng + 7 * D, nullptr, gw, NGW, lane); }
        SEAM(pb + 11);
    }
#undef IN
#undef SEAM
}

#ifndef MK_MULTI
#define MK_MULTI 0
#endif
extern "C" void kernel_launch(void* const* d_in, const int* in_sizes, int n_in, void* d_out, int out_size, void* d_ws, size_t ws_size, hipStream_t stream) {
    static int grid = 0;
    if (grid == 0) {
        if (n_in != 17 || in_sizes[0] != M * D || out_size != M * D || ws_size < WS_END) { fprintf(stderr, "kernel_launch: unexpected shapes (n_in %d, in0 %d, out %d, ws %zu < %zu)\n", n_in, n_in > 0 ? in_sizes[0] : -1, out_size, ws_size, (size_t)WS_END); grid = -1; return; }
        int dev = 0, cus = 0, per_cu = 0;
        if (hipGetDevice(&dev) != hipSuccess || hipDeviceGetAttribute(&cus, hipDeviceAttributeMultiprocessorCount, dev) != hipSuccess) { grid = -1; return; }
        if (hipFuncSetAttribute((const void*)mega_fwd, hipFuncAttributeMaxDynamicSharedMemorySize, LDS_BYTES) != hipSuccess) { fprintf(stderr, "kernel_launch: hipFuncSetAttribute failed\n"); grid = -1; return; }
        if (hipOccupancyMaxActiveBlocksPerMultiprocessor(&per_cu, (const void*)mega_fwd, 512, LDS_BYTES) != hipSuccess || per_cu < 1) { fprintf(stderr, "kernel_launch: occupancy query reports %d\n", per_cu); }
        (void)hipGetLastError();
        grid = cus;
    }
    if (grid < 0) return;
    (void)hipMemsetAsync((char*)d_ws + WS_CTL, 0, CTL_ZERO_BYTES, stream);
    Args a{};
    for (int i = 0; i < 17; ++i) a.in[i] = (const float*)d_in[i];
    a.out = (float*)d_out; a.ws = (unsigned char*)d_ws;
#if MK_MULTI
    for (int p = 0; p < NPH; ++p) { a.ph_lo = p; a.ph_hi = p + 1; hipLaunchKernelGGL(mega_fwd, dim3(grid), dim3(512), LDS_BYTES, stream, a); }
#else
    a.ph_lo = 0; a.ph_hi = NPH;
    hipLaunchKernelGGL(mega_fwd, dim3(grid), dim3(512), LDS_BYTES, stream, a);
#endif
    const hipError_t le = hipPeekAtLastError();
    if (le != hipSuccess) fprintf(stderr, "kernel_launch: launch failed: %s\n", hipGetErrorName(le));
}
```

```cpp
#include <hip/hip_runtime.h>
#include <cstdio>
#include <cstdint>

#define LAS __attribute__((address_space(3)))
typedef unsigned short bf16_t;
typedef short bf16x8 __attribute__((ext_vector_type(8)));
typedef short s16x4 __attribute__((ext_vector_type(4)));
typedef float f32x4 __attribute__((ext_vector_type(4)));
typedef float f32x2 __attribute__((ext_vector_type(2)));
typedef unsigned u32x4 __attribute__((ext_vector_type(4)));
typedef unsigned u32x2 __attribute__((ext_vector_type(2)));

namespace pg8 {
constexpr int BM = 256, BK = 64, HALF = 128, HTB = HALF * BK * 2, STAGE_BYTES = 8 * HTB, NXCD = 8, WGM = 8;
__host__ __device__ __forceinline__ int lds_byte(int r, int c) { const int st = (r >> 4) * 2 + (c >> 5), rr = r & 15, cc = c & 31, ob = rr * 64 + cc * 2; return st * 1024 + (ob ^ (((ob >> 9) & 1) << 5)); }
__host__ __device__ __forceinline__ void stage_rc(int b, int& R, int& C) { const int st = b / 1024, sb = b % 1024, swz = sb ^ (((sb >> 9) & 1) << 5); R = (st >> 1) * 16 + swz / 64; C = (st & 1) * 32 + (swz % 64) / 2; }
__host__ __device__ __forceinline__ int perm32(int rho) { const int n = rho >> 4, i = rho & 15; return 8 * (i >> 2) + 4 * n + (i & 3); }
struct Unit { int pm, pn; };
struct Gemm { const bf16_t* A; const bf16_t* Bt; int M, N, K; };
struct StaticOrder {
    int nM, nN, nwg, G, c;
    __host__ __device__ void init(int M, int N, int G_, int c_) { nM = M / BM; nN = N / BM; nwg = nM * nN; G = G_; c = c_; }
    __host__ __device__ bool next(int i, Unit& u) const {
        const long L = (long)i * G + c; if (L >= nwg) return false;
        int wgid = (int)L; { const int q = nwg / NXCD, r = nwg % NXCD, xcd = wgid % NXCD, off = wgid / NXCD; wgid = (xcd < r ? xcd * (q + 1) : r * (q + 1) + (xcd - r) * q) + off; }
        const int nig = WGM * nN, gid = wgid / nig, fm = gid * WGM, gsz = (nM - fm) < WGM ? (nM - fm) : WGM;
        u.pm = fm + ((wgid % nig) % gsz); u.pn = (wgid % nig) / gsz; return true;
    }
    __device__ __forceinline__ void a_ready(const Unit&) const {}
    __device__ __forceinline__ void done(const Unit&) const {}
};
__device__ __forceinline__ unsigned cvt_pk_bf16(float lo, float hi) { unsigned r; asm volatile("v_cvt_pk_bf16_f32 %0, %1, %2" : "=v"(r) : "v"(lo), "v"(hi)); return r; }

typedef int i32x4 __attribute__((ext_vector_type(4)));
typedef int i32x8 __attribute__((ext_vector_type(8)));
template <bool F8>
__device__ __forceinline__ void mma_blk(f32x4 (&c)[4][2], const bf16x8 (&At)[4][2], const bf16x8 (&Bt)[2][2]) {
    __builtin_amdgcn_s_setprio(1);
    if constexpr (F8) {
#pragma unroll
        for (int m = 0; m < 4; ++m)
#pragma unroll
            for (int n = 0; n < 2; ++n) {
                const i32x8 b8 = __builtin_shufflevector(__builtin_bit_cast(i32x4, Bt[n][0]), __builtin_bit_cast(i32x4, Bt[n][1]), 0, 1, 2, 3, 4, 5, 6, 7);
                const i32x8 a8 = __builtin_shufflevector(__builtin_bit_cast(i32x4, At[m][0]), __builtin_bit_cast(i32x4, At[m][1]), 0, 1, 2, 3, 4, 5, 6, 7);
                c[m][n] = __builtin_amdgcn_mfma_scale_f32_16x16x128_f8f6f4(b8, a8, c[m][n], 0, 0, 0, 0, 0, 0); }
    } else {
#pragma unroll
        for (int m = 0; m < 4; ++m)
#pragma unroll
            for (int n = 0; n < 2; ++n)
#pragma unroll
                for (int k = 0; k < 2; ++k) c[m][n] = __builtin_amdgcn_mfma_f32_16x16x32_bf16(Bt[n][k], At[m][k], c[m][n], 0, 0, 0);
    }
    __builtin_amdgcn_s_setprio(0);
}
template <class Epi, class Sched, bool ALIGN_EPI = false, bool SP2 = false, bool F8 = false>
__device__ __forceinline__ void gemm_phase(LAS unsigned char* lds, const Gemm g, const Sched& S, const Epi& E) {
    int tid_ = threadIdx.x; asm volatile("" : "+v"(tid_));
    const int tid = tid_, wid = __builtin_amdgcn_readfirstlane(tid >> 6), lane = tid & 63, wr = wid >> 2, wc = wid & 3, fr = lane & 15, fq = lane >> 4;
    const int K = g.K, nt = K / BK;
    unsigned voffA, voffB;
    { int R, C; stage_rc(tid * 16, R, C); const int Rb = Epi::PERM ? ((R & ~31) + perm32(R & 31)) : R;
      voffA = (unsigned)(R * K + C) * 2u; voffB = (unsigned)(Rb * K + C) * 2u; }
    const size_t rstep = (size_t)64 * K * 2;
    const size_t kstep = (size_t)(BK * 2);
    const size_t hstep = (size_t)HALF * K * 2;
    const size_t tstep = 2 * hstep;
    const unsigned ldsw = (unsigned)wid * 1024u;
    const int aoff = lds_byte(wr * 64 + fr, fq * 8), boff = lds_byte(wc * 32 + fr, fq * 8);
#define PG8_SA(b, h) (((b) * 2 + (h)) * HTB)
#define PG8_SB(b, h) ((4 + (b) * 2 + (h)) * HTB)
#define PG8_STAGE(bufoff, gbase, voff) do { _Pragma("unroll") for (int _i = 0; _i < 2; ++_i) { if constexpr (F8) asm volatile("" : "+v"(voff));     \
        __builtin_amdgcn_global_load_lds((const unsigned*)((const char*)(gbase) + _i * rstep + (voff)), (LAS unsigned*)(lds + (bufoff) + ldsw + _i * 8192), 16, 0, 0); } } while (0)
#define PG8_LDA(dst, b, h) do { _Pragma("unroll") for (int m = 0; m < 4; ++m) _Pragma("unroll") for (int k = 0; k < 2; ++k) dst[m][k] = *(const LAS bf16x8*)(lds + PG8_SA(b, h) + aoff + m * 2048 + k * 1024); } while (0)
#define PG8_LDB(dst, b, h) do { _Pragma("unroll") for (int n = 0; n < 2; ++n) _Pragma("unroll") for (int k = 0; k < 2; ++k) dst[n][k] = *(const LAS bf16x8*)(lds + PG8_SB(b, h) + boff + n * 2048 + k * 1024); } while (0)
#define PG8_MMA(ai, bj, At, Bt) mma_blk<F8>(acc[ai][bj], At, Bt)
#define PG8_WAIT_V(n) asm volatile("s_waitcnt vmcnt(" #n ")" ::: "memory")
#define PG8_WAIT_L(n) asm volatile("s_waitcnt lgkmcnt(" #n ")" ::: "memory")
#define PG8_BAR __builtin_amdgcn_s_barrier()
#define PG8_SCHED __builtin_amdgcn_sched_barrier(0)
    Unit cur, nxt; int ui = 0;
    if (!S.next(0, cur)) return;
    f32x4 acc[2][2][4][2];
#pragma unroll
    for (int a = 0; a < 2; ++a)
#pragma unroll
        for (int b = 0; b < 2; ++b)
#pragma unroll
            for (int m = 0; m < 4; ++m)
#pragma unroll
                for (int n = 0; n < 2; ++n) acc[a][b][m][n] = (f32x4){0.f, 0.f, 0.f, 0.f};
    bf16x8 At[4][2], B0[2][2], B1[2][2];
    const char* cA = (const char*)g.A + (size_t)cur.pm * tstep; const char* cB = (const char*)g.Bt + (size_t)cur.pn * tstep;
    S.a_ready(cur);
    if constexpr (SP2) {
        PG8_STAGE(PG8_SB(0, 0), cB, voffB); PG8_STAGE(PG8_SB(0, 1), cB + hstep, voffB); PG8_STAGE(PG8_SA(0, 0), cA, voffA); PG8_STAGE(PG8_SA(0, 1), cA + hstep, voffA);
        if (wr == 1) PG8_BAR;
        PG8_WAIT_V(2); PG8_BAR;
        PG8_STAGE(PG8_SB(1, 0), cB + kstep, voffB); PG8_STAGE(PG8_SA(1, 0), cA + kstep, voffA); PG8_STAGE(PG8_SB(1, 1), cB + hstep + kstep, voffB);
        PG8_WAIT_V(6); PG8_BAR;
    } else {
        PG8_STAGE(PG8_SB(0, 0), cB, voffB); PG8_STAGE(PG8_SA(0, 0), cA, voffA); PG8_STAGE(PG8_SB(0, 1), cB + hstep, voffB); PG8_STAGE(PG8_SA(0, 1), cA + hstep, voffA);
        if (wr == 1) PG8_BAR;
        PG8_WAIT_V(4); PG8_BAR;
        PG8_STAGE(PG8_SB(1, 0), cB + kstep, voffB); PG8_STAGE(PG8_SA(1, 0), cA + kstep, voffA); PG8_STAGE(PG8_SB(1, 1), cB + hstep + kstep, voffB);
        PG8_WAIT_V(6); PG8_BAR;
    }
    for (;;) {
        const bool has_next = S.next(ui + 1, nxt);
        const char* nA = has_next ? (const char*)g.A + (size_t)nxt.pm * tstep : cA; const char* nB = has_next ? (const char*)g.Bt + (size_t)nxt.pn * tstep : cB;
        for (int t = 0; t < nt; t += 2) {
            const bool last = (t == nt - 2);
            const char* a1 = cA + (size_t)(t + 1) * kstep;
            const char* a2 = last ? nA : cA + (size_t)(t + 2) * kstep; const char* b2 = last ? nB : cB + (size_t)(t + 2) * kstep;
            const char* a3 = a2 + kstep; const char* b3 = b2 + kstep;
            if (last && has_next) S.a_ready(nxt);
            if constexpr (SP2) {
            PG8_LDB(B0, 0, 0); PG8_LDB(B1, 0, 1); PG8_SCHED; PG8_LDA(At, 0, 0); PG8_STAGE(PG8_SA(1, 1), a1 + hstep, voffA);
            PG8_WAIT_V(8); PG8_WAIT_L(0); PG8_BAR; PG8_MMA(0, 0, At, B0); PG8_MMA(0, 1, At, B1); PG8_BAR; PG8_SCHED;
            PG8_LDA(At, 0, 1); PG8_STAGE(PG8_SB(0, 0), b2, voffB); PG8_STAGE(PG8_SB(0, 1), b2 + hstep, voffB); PG8_STAGE(PG8_SA(0, 0), a2, voffA);
            PG8_WAIT_V(8); PG8_WAIT_L(0); PG8_BAR; PG8_MMA(1, 0, At, B0); PG8_MMA(1, 1, At, B1); PG8_BAR; PG8_SCHED;
            PG8_LDB(B0, 1, 0); PG8_LDB(B1, 1, 1); PG8_SCHED; PG8_LDA(At, 1, 0); PG8_STAGE(PG8_SA(0, 1), a2 + hstep, voffA);
            PG8_WAIT_V(8); PG8_WAIT_L(0); PG8_BAR; PG8_MMA(0, 0, At, B0); PG8_MMA(0, 1, At, B1); PG8_BAR; PG8_SCHED;
            PG8_LDA(At, 1, 1); PG8_STAGE(PG8_SB(1, 0), b3, voffB); PG8_STAGE(PG8_SB(1, 1), b3 + hstep, voffB); PG8_STAGE(PG8_SA(1, 0), a3, voffA);
            PG8_WAIT_V(8); PG8_WAIT_L(0); PG8_BAR; PG8_MMA(1, 0, At, B0); PG8_MMA(1, 1, At, B1); PG8_BAR; PG8_SCHED;
            } else {
            PG8_LDB(B0, 0, 0); PG8_SCHED; PG8_LDA(At, 0, 0); PG8_STAGE(PG8_SA(1, 1), a1 + hstep, voffA);
            PG8_WAIT_L(8); PG8_BAR; PG8_WAIT_L(0); PG8_MMA(0, 0, At, B0); PG8_BAR; PG8_SCHED;
            PG8_LDB(B1, 0, 1); PG8_STAGE(PG8_SB(0, 0), b2, voffB);
            PG8_BAR; PG8_WAIT_L(0); PG8_MMA(0, 1, At, B1); PG8_BAR;
            PG8_LDA(At, 0, 1); PG8_STAGE(PG8_SA(0, 0), a2, voffA);
            PG8_BAR; PG8_WAIT_L(0); PG8_MMA(1, 0, At, B0); PG8_BAR; PG8_SCHED;
            PG8_STAGE(PG8_SB(0, 1), b2 + hstep, voffB);
            PG8_WAIT_V(6); PG8_BAR; PG8_MMA(1, 1, At, B1); PG8_BAR;
            PG8_LDB(B0, 1, 0); PG8_SCHED; PG8_LDA(At, 1, 0); PG8_STAGE(PG8_SA(0, 1), a2 + hstep, voffA);
            PG8_WAIT_L(8); PG8_BAR; PG8_WAIT_L(0); PG8_MMA(0, 0, At, B0); PG8_BAR; PG8_SCHED;
            PG8_LDB(B1, 1, 1); PG8_STAGE(PG8_SB(1, 0), b3, voffB);
            PG8_BAR; PG8_WAIT_L(0); PG8_MMA(0, 1, At, B1); PG8_BAR;
            PG8_LDA(At, 1, 1); PG8_STAGE(PG8_SA(1, 0), a3, voffA);
            PG8_BAR; PG8_WAIT_L(0); PG8_MMA(1, 0, At, B0); PG8_BAR; PG8_SCHED;
            PG8_STAGE(PG8_SB(1, 1), b3 + hstep, voffB);
            PG8_WAIT_V(6); PG8_BAR; PG8_MMA(1, 1, At, B1); PG8_BAR;
            }
        }
        if constexpr (ALIGN_EPI) { if (wr == 0) PG8_BAR; }
        { const int ln = __builtin_amdgcn_mbcnt_hi(~0u, __builtin_amdgcn_mbcnt_lo(~0u, 0u));
          E(acc, cur, wr, wc, ln & 15, ln >> 4); } S.done(cur);
        if (!has_next) break;
#pragma unroll
        for (int a = 0; a < 2; ++a)
#pragma unroll
            for (int b = 0; b < 2; ++b)
#pragma unroll
                for (int m = 0; m < 4; ++m)
#pragma unroll
                    for (int n = 0; n < 2; ++n) acc[a][b][m][n] = (f32x4){0.f, 0.f, 0.f, 0.f};
        cur = nxt; cA = nA; cB = nB; ++ui;
        if constexpr (ALIGN_EPI) { if (wr == 1) PG8_BAR; }
    }
    PG8_WAIT_V(0);
    if constexpr (!ALIGN_EPI) { if (wr == 0) PG8_BAR; }
    PG8_BAR;
#undef PG8_SA
#undef PG8_SB
#undef PG8_STAGE
#undef PG8_LDA
#undef PG8_LDB
#undef PG8_MMA
#undef PG8_WAIT_V
#undef PG8_WAIT_L
#undef PG8_BAR
#undef PG8_SCHED
}
}

constexpr int NB = 16, SEQ = 2048, D = 2048, M = NB * SEQ, FF = 5632, DEPTH = 4, PLE = 256;
constexpr float EPS = 1e-6f;
constexpr float QSCALE_MOBA = 0.08838834764831845f * 1.4426950408889634f;

constexpr size_t MiB = 1u << 20;
constexpr size_t WS_CTL = 0, WS_KSUM = 1 * MiB, CTL_ZERO_BYTES = 2 * MiB;
constexpr size_t WS_RCOS = 2 * MiB, WS_RSIN = 3 * MiB, WS_MCOS = 4 * MiB, WS_MSIN = 4 * MiB + 128 * 1024;
constexpr size_t WS_SGUW = 5 * MiB, WS_POOLW = 6 * MiB, WS_RS = 7 * MiB;
constexpr size_t WS_WGU = 8 * MiB, WS_WDN = 360 * MiB, WS_WINE = 536 * MiB, WS_WINO = 584 * MiB, WS_WOUT = 616 * MiB, WS_WPG = 648 * MiB, WS_WPP = 680 * MiB;
constexpr size_t WS_PBF = 684 * MiB, WS_H = 748 * MiB, WS_T = 876 * MiB, WS_Y = 1004 * MiB, WS_BIG = 1132 * MiB, WS_X8 = 1516 * MiB, WS_END = 1580 * MiB;
constexpr size_t SZ_WGU = (size_t)2 * FF * D * 2, SZ_WDN = (size_t)D * FF * 2;
constexpr int CW_BAR = 4096;

constexpr int RING_BYTES = 131072, LDS_BYTES = 147456, MISC_OFF = LDS_BYTES - 64;

#define XB_TMO      128
#define XB_XCNT(j)  (256  + 64 * (j))
#define XB_XSUB(j)  (1280 + 64 * (j))
#define XB_XGEN(j)  (2304 + 64 * (j))
#define XB_TOP      3328
#define XB_TOPGEN   3392
#define XCD_BAR_WORDS 3456
#define XB_SPIN_CAP (1u << 18)
__device__ __forceinline__ unsigned xb_ld(unsigned* p)              { return __hip_atomic_load(p, __ATOMIC_RELAXED, __HIP_MEMORY_SCOPE_AGENT); }
__device__ __forceinline__ unsigned xb_add(unsigned* p, unsigned v) { return __hip_atomic_fetch_add(p, v, __ATOMIC_RELAXED, __HIP_MEMORY_SCOPE_AGENT); }
__device__ __forceinline__ unsigned xb_xcc_id() { return (unsigned)__builtin_amdgcn_s_getreg((3 << 11) | 20) & 0xFu; }
#define XB_SPIN(cond, bar) do { unsigned _sp = 0; while (cond) { __builtin_amdgcn_s_sleep(1); \
    if ((++_sp & 255u) == 0u) { if (xb_ld(&(bar)[XB_TMO])) break; if (_sp > XB_SPIN_CAP) { atomicAdd(&(bar)[XB_TMO], 1u); break; } } } } while (0)
struct XcdBarrier { unsigned* bar; unsigned x; volatile LAS unsigned* st; };
__device__ __forceinline__ XcdBarrier xcd_barrier_post(unsigned* bar, volatile LAS unsigned* st) {
    XcdBarrier b; b.bar = bar; b.x = xb_xcc_id(); b.st = st;
    if (threadIdx.x == 0) (void)xb_add(&bar[XB_XCNT(b.x)], 1u);
    return b;
}
__device__ __forceinline__ void xcd_barrier_complete(unsigned* bar, unsigned x, unsigned& nloc, unsigned& nx) {
    const unsigned G = gridDim.x * gridDim.y * gridDim.z;
    unsigned sum, cnt, mine, sp = 0u;
    for (;;) {
        sum = 0u; cnt = 0u; mine = 0u;
#pragma unroll
        for (unsigned j = 0; j < 16; ++j) { const unsigned c = xb_ld(&bar[XB_XCNT(j)]); sum += c; cnt += (c > 0u) ? 1u : 0u; mine = (j == x) ? c : mine; }
        if (sum == G) break;
        __builtin_amdgcn_s_sleep(1);
        if ((++sp & 255u) == 0u) { if (xb_ld(&bar[XB_TMO])) break; if (sp > XB_SPIN_CAP) { atomicAdd(&bar[XB_TMO], 1u); break; } }
    }
    nloc = mine > 0u ? mine : 1u; nx = cnt > 0u ? cnt : 1u;
}
__device__ __forceinline__ void xcd_barrier(const XcdBarrier& b) {
    asm volatile("s_waitcnt vmcnt(0)" ::: "memory");
    __syncthreads();
    if (threadIdx.x == 0) {
        unsigned* bar = b.bar;
        __builtin_amdgcn_s_waitcnt(0);
        unsigned nloc = b.st[0], nx = b.st[1];
        if (nloc == 0u) { xcd_barrier_complete(bar, b.x, nloc, nx); b.st[0] = nloc; b.st[1] = nx; }
        const unsigned old = xb_add(&bar[XB_XSUB(b.x)], 1u);
        const unsigned gen = old / nloc;
        if (old + 1u == (gen + 1u) * nloc) {
            __builtin_amdgcn_fence(__ATOMIC_RELEASE, "agent");
            asm volatile("s_waitcnt vmcnt(0)" ::: "memory");
            const unsigned og = xb_add(&bar[XB_TOP], 1u);
            const unsigned tg = og / nx;
            if (og + 1u == (tg + 1u) * nx) xb_add(&bar[XB_TOPGEN], 1u);
            else XB_SPIN(xb_ld(&bar[XB_TOPGEN]) == tg, bar);
            __builtin_amdgcn_fence(__ATOMIC_ACQUIRE, "agent");
            xb_add(&bar[XB_XGEN(b.x)], 1u);
            asm volatile("s_waitcnt vmcnt(0)" ::: "memory");
        } else {
            XB_SPIN(xb_ld(&bar[XB_XGEN(b.x)]) == gen, bar);
            __builtin_amdgcn_fence(__ATOMIC_ACQUIRE, "agent");
            asm volatile("s_waitcnt vmcnt(0)" ::: "memory");
        }
    }
    __syncthreads();
}

#define LDS_WAIT() asm volatile("s_waitcnt lgkmcnt(0)" ::: "memory")
__device__ __forceinline__ unsigned f2bf(float f) { unsigned u = __builtin_bit_cast(unsigned, f); return (u + 0x7fffu + ((u >> 16) & 1u)) >> 16; }
__device__ __forceinline__ unsigned pk2(float lo, float hi) { return f2bf(lo) | (f2bf(hi) << 16); }
__device__ __forceinline__ float bf_lo(unsigned w) { return __builtin_bit_cast(float, w << 16); }
__device__ __forceinline__ float bf_hi(unsigned w) { return __builtin_bit_cast(float, w & 0xffff0000u); }
__device__ __forceinline__ float wave_sum(float v) {
#pragma unroll
    for (int o = 1; o < 64; o <<= 1) v += __shfl_xor(v, o);
    return v;
}
__device__ __forceinline__ float silu_f(float x) { return x * __builtin_amdgcn_rcpf(1.f + __expf(-x)); }
__device__ __forceinline__ float sigmoid_f(float x) { return __builtin_amdgcn_rcpf(1.f + __expf(-x)); }
__device__ __forceinline__ float gelu_tanh_f(float x) {
    const float u = 0.7978845608028654f * (x + 0.044715f * x * x * x);
    return x * __builtin_amdgcn_rcpf(1.f + __expf(-2.f * u));
}
__device__ __forceinline__ f32x2 rcp_pk(f32x2 d) { f32x2 r; r.x = __builtin_amdgcn_rcpf(d.x); r.y = __builtin_amdgcn_rcpf(d.y); return r; }
__device__ __forceinline__ f32x2 exp2_pk(f32x2 t) { f32x2 e; e.x = __builtin_amdgcn_exp2f(t.x); e.y = __builtin_amdgcn_exp2f(t.y); return e; }
__device__ __forceinline__ f32x2 sigmoid_pk(f32x2 x) { return rcp_pk(exp2_pk(x * (-1.4426950408889634f)) + 1.0f); }
__device__ __forceinline__ f32x2 gelu_tanh_pk(f32x2 x) {
    const f32x2 p = (x * x) * (-0.10294324f) + (-2.3022082f);
    return x * rcp_pk(exp2_pk(x * p) + 1.0f);
}
__device__ __forceinline__ f32x4 silu_mul4(const f32x4& g, const f32x4& u) {
    const f32x2 g0 = (f32x2){g[0], g[1]}, g1 = (f32x2){g[2], g[3]}, u0 = (f32x2){u[0], u[1]}, u1 = (f32x2){u[2], u[3]};
    const f32x2 o0 = (g0 * u0) * sigmoid_pk(g0), o1 = (g1 * u1) * sigmoid_pk(g1);
    return (f32x4){o0.x, o0.y, o1.x, o1.y};
}
__device__ __forceinline__ f32x4 silu_mul4r(const f32x4& g, const f32x4& u, float c, float ir2) {
    f32x4 o;
#pragma unroll
    for (int i = 0; i < 4; ++i) { const float e = __builtin_amdgcn_exp2f((g[i] * c));
        o[i] = (g[i] * u[i]) * __builtin_amdgcn_rcpf(__builtin_fmaf(e, ir2, ir2)); }
    return o;
}
__device__ __forceinline__ f32x4 silu4r(const f32x4& a, float c, float ir) {
    f32x4 o;
#pragma unroll
    for (int i = 0; i < 4; ++i) o[i] = a[i] * __builtin_amdgcn_rcpf(__builtin_fmaf(__builtin_amdgcn_exp2f(a[i] * c), ir, ir));
    return o;
}
__device__ __forceinline__ f32x4 gelu4r(const f32x4& a, float Ar, float Br3, float ir) {
    f32x4 o;
#pragma unroll
    for (int i = 0; i < 4; ++i) o[i] = a[i] * __builtin_amdgcn_rcpf(__builtin_fmaf(__builtin_amdgcn_exp2f(a[i] * __builtin_fmaf(a[i] * a[i], Br3, Ar)), ir, ir));
    return o;
}
__device__ __forceinline__ f32x4 silu4(const f32x4& g) {
    const f32x2 g0 = (f32x2){g[0], g[1]}, g1 = (f32x2){g[2], g[3]};
    const f32x2 o0 = g0 * sigmoid_pk(g0), o1 = g1 * sigmoid_pk(g1);
    return (f32x4){o0.x, o0.y, o1.x, o1.y};
}
__device__ __forceinline__ f32x4 gelu4(const f32x4& x) {
    const f32x2 o0 = gelu_tanh_pk((f32x2){x[0], x[1]}), o1 = gelu_tanh_pk((f32x2){x[2], x[3]});
    return (f32x4){o0.x, o0.y, o1.x, o1.y};
}
__device__ __forceinline__ f32x4 sigmoid_mul4r(const f32x4& a, float c, float p0, float p1, float p2, float p3) {
    const f32x2 o0 = rcp_pk(exp2_pk((f32x2){a[0], a[1]} * c) + 1.0f) * (f32x2){p0, p1}, o1 = rcp_pk(exp2_pk((f32x2){a[2], a[3]} * c) + 1.0f) * (f32x2){p2, p3};
    return (f32x4){o0.x, o0.y, o1.x, o1.y};
}
__device__ __forceinline__ f32x4 sigmoid_mul4(const f32x4& a, float p0, float p1, float p2, float p3) {
    const f32x2 o0 = sigmoid_pk((f32x2){a[0], a[1]}) * (f32x2){p0, p1}, o1 = sigmoid_pk((f32x2){a[2], a[3]}) * (f32x2){p2, p3};
    return (f32x4){o0.x, o0.y, o1.x, o1.y};
}
__device__ __forceinline__ u32x4 pack8(const f32x4& a, const f32x4& b) {
    u32x4 w; w.x = pg8::cvt_pk_bf16(a[0], a[1]); w.y = pg8::cvt_pk_bf16(a[2], a[3]); w.z = pg8::cvt_pk_bf16(b[0], b[1]); w.w = pg8::cvt_pk_bf16(b[2], b[3]); return w;
}

#ifndef GU_F8_MASK
#define GU_F8_MASK 0xE0
#endif
#ifndef DN_F8_MASK
#define DN_F8_MASK 0xE0
#endif
__device__ __forceinline__ float ld_rs(const float* rs, int row0, int imm) { return *(const float*)((const unsigned char*)rs + ((unsigned)row0 << 2) + (unsigned)(imm * 4)); }
typedef f32x4 AccT[2][2][4][2];
struct EpiPlain {
    static constexpr bool PERM = true;
    bf16_t* O; int ldc; int gelu_pm;
    __device__ __forceinline__ void operator()(const AccT& acc, const pg8::Unit& u, int wr, int wc, int fr, int fq) const {
        const int row0 = u.pm * 256 + wr * 64 + fr, col0 = u.pn * 256 + wc * 32 + 8 * fq;
        const bool gl = u.pm >= gelu_pm;
#pragma unroll
        for (int ai = 0; ai < 2; ++ai)
#pragma unroll
            for (int m = 0; m < 4; ++m) { bf16_t* rowp = O + (size_t)(row0 + ai * 128 + m * 16) * ldc + col0;
#pragma unroll
                for (int bj = 0; bj < 2; ++bj) { f32x4 v0 = acc[ai][bj][m][0], v1 = acc[ai][bj][m][1];
                    if (gl) { v0 = gelu4(v0); v1 = gelu4(v1); }
                    *(u32x4*)(rowp + bj * 128) = pack8(v0, v1); } }
    }
};
struct EpiPlainT {
    static constexpr bool PERM = true;
    bf16_t* O; int ldc; int gelu_pm; const float* rs;
    __device__ __forceinline__ void operator()(const AccT& acc, const pg8::Unit& u, int wr, int wc, int fr, int fq) const {
        const int row0 = u.pm * 256 + wr * 64 + fr, col0 = u.pn * 256 + wc * 32 + 8 * fq;
        const bool gl = u.pm >= gelu_pm;
        f32x4 cs[2][2];
#pragma unroll
        for (int bj = 0; bj < 2; ++bj)
#pragma unroll
            for (int n = 0; n < 2; ++n) cs[bj][n] = *(const f32x4*)(rs + col0 + bj * 128 + 4 * n);
#pragma unroll
        for (int ai = 0; ai < 2; ++ai)
#pragma unroll
            for (int m = 0; m < 4; ++m) { bf16_t* rowp = O + (size_t)(row0 + ai * 128 + m * 16) * ldc + col0;
#pragma unroll
                for (int bj = 0; bj < 2; ++bj) { f32x4 v0 = acc[ai][bj][m][0] * cs[bj][0], v1 = acc[ai][bj][m][1] * cs[bj][1];
                    if (gl) { v0 = gelu4(v0); v1 = gelu4(v1); }
                    *(u32x4*)(rowp + bj * 128) = pack8(v0, v1); } }
    }
};
struct EpiGU {
    static constexpr bool PERM = true;
    bf16_t* O; const float* rs;
    __device__ __forceinline__ void operator()(const AccT& acc, const pg8::Unit& u, int wr, int wc, int fr, int fq) const {
        const int row0 = u.pm * 256 + wr * 64 + fr, col0 = u.pn * 128 + wc * 32 + 8 * fq;
        float rv[2][4];
#pragma unroll
        for (int ai = 0; ai < 2; ++ai)
#pragma unroll
            for (int m = 0; m < 4; ++m) rv[ai][m] = ld_rs(rs, row0, ai * 128 + m * 16);
#pragma unroll
        for (int ai = 0; ai < 2; ++ai)
#pragma unroll
            for (int m = 0; m < 4; ++m) { bf16_t* rowp = O + (size_t)(row0 + ai * 128 + m * 16) * FF + col0; const float r = rv[ai][m], c = r * -1.4426950408889634f, r2 = __builtin_amdgcn_rcpf(r * r);
                const f32x4 o0 = silu_mul4r(acc[ai][0][m][0], acc[ai][1][m][0], c, r2), o1 = silu_mul4r(acc[ai][0][m][1], acc[ai][1][m][1], c, r2);
                *(u32x4*)rowp = pack8(o0, o1); }
    }
};
__host__ __device__ constexpr bool dn_f8(int L, int f) { return (DN_F8_MASK >> (L * 2 + f)) & 1; }
__host__ __device__ constexpr bool gu_f8(int L, int f) { return (GU_F8_MASK >> (L * 2 + f)) & 1; }
static_assert((GU_F8_MASK & ~DN_F8_MASK) == 0, "an fp8 gate/up GEMM writes fp8 output: its down GEMM must be fp8 as well");
constexpr float F8_XSCALE = 8.f, F8_WGSCALE = 128.f;
constexpr float F8_ASCALE = 8.f, F8_WSCALE = 256.f;
__device__ __forceinline__ unsigned pack4_fp8(const f32x4& v) {
    int w = 0;
    w = __builtin_amdgcn_cvt_pk_fp8_f32(__builtin_amdgcn_fmed3f(v[0], -448.f, 448.f), __builtin_amdgcn_fmed3f(v[1], -448.f, 448.f), w, false);
    w = __builtin_amdgcn_cvt_pk_fp8_f32(__builtin_amdgcn_fmed3f(v[2], -448.f, 448.f), __builtin_amdgcn_fmed3f(v[3], -448.f, 448.f), w, true);
    return (unsigned)w;
}
struct EpiGU8 {
    static constexpr bool PERM = true;
    unsigned char* O; const float* rs; float sc;
    __device__ __forceinline__ void operator()(const AccT& acc, const pg8::Unit& u, int wr, int wc, int fr, int fq) const {
        asm volatile("" : "+v"(fr), "+v"(fq));
        const int row0 = u.pm * 256 + wr * 64 + fr, col0 = u.pn * 128 + wc * 32 + 8 * fq;
        float rv[2][4];
#pragma unroll
        for (int ai = 0; ai < 2; ++ai)
#pragma unroll
            for (int m = 0; m < 4; ++m) rv[ai][m] = ld_rs(rs, row0, ai * 128 + m * 16);
#pragma unroll
        for (int ai = 0; ai < 2; ++ai)
#pragma unroll
            for (int m = 0; m < 4; ++m) { unsigned char* rowp = O + (size_t)(row0 + ai * 128 + m * 16) * FF + col0; const float r = rv[ai][m] * sc, c = r * -1.4426950408889634f, r2 = __builtin_amdgcn_rcpf(r * r * F8_ASCALE);
                const f32x4 o0 = silu_mul4r(acc[ai][0][m][0], acc[ai][1][m][0], c, r2), o1 = silu_mul4r(acc[ai][0][m][1], acc[ai][1][m][1], c, r2);
                u32x2 w; w.x = pack4_fp8(o0); w.y = pack4_fp8(o1);
                *(u32x2*)rowp = w; }
    }
};
struct EpiPlainS {
    static constexpr bool PERM = true;
    bf16_t* O; int ldc; float sc;
    __device__ __forceinline__ void operator()(const AccT& acc, const pg8::Unit& u, int wr, int wc, int fr, int fq) const {
        asm volatile("" : "+v"(fr), "+v"(fq));
        const int row0 = u.pm * 256 + wr * 64 + fr, col0 = u.pn * 256 + wc * 32 + 8 * fq;
#pragma unroll
        for (int ai = 0; ai < 2; ++ai)
#pragma unroll
            for (int m = 0; m < 4; ++m) { bf16_t* rowp = O + (size_t)(row0 + ai * 128 + m * 16) * ldc + col0;
#pragma unroll
                for (int bj = 0; bj < 2; ++bj) *(u32x4*)(rowp + bj * 128) = pack8(acc[ai][bj][m][0] * sc, acc[ai][bj][m][1] * sc); }
    }
};
struct EpiInEven {
    static constexpr bool PERM = true;
    bf16_t* O; const float* rcos; const float* rsin; const float* rs;
    __device__ __forceinline__ void operator()(const AccT& acc, const pg8::Unit& u, int wr, int wc, int fr, int fq) const {
        const int row0 = u.pm * 256 + wr * 64 + fr, col0 = u.pn * 256 + wc * 32 + 8 * fq;
        float rv[2][4];
#pragma unroll
        for (int ai = 0; ai < 2; ++ai)
#pragma unroll
            for (int m = 0; m < 4; ++m) rv[ai][m] = ld_rs(rs, row0, ai * 128 + m * 16);
        if (u.pn < 8) {
            const float ksc = u.pn >= 4 ? 0.0625f : 1.f;
#pragma unroll
            for (int ai = 0; ai < 2; ++ai) { f32x4 ctab[4][2], stab[4][2];
#pragma unroll
                for (int m = 0; m < 4; ++m)
#pragma unroll
                    for (int n = 0; n < 2; ++n) { const int tp = (row0 + ai * 128 + m * 16) & (SEQ - 1), i0 = wc * 32 + 8 * fq + 4 * n; ctab[m][n] = *(const f32x4*)(rcos + tp * 128 + i0); stab[m][n] = *(const f32x4*)(rsin + tp * 128 + i0); }
#pragma unroll
                for (int m = 0; m < 4; ++m) { const int row = row0 + ai * 128 + m * 16; bf16_t* rowp = O + (size_t)row * 4096 + col0;
                    f32x4 o1[2], o2[2]; const float kr = ksc * rv[ai][m];
#pragma unroll
                    for (int n = 0; n < 2; ++n) {
                        const f32x4 c4 = ctab[m][n], s4 = stab[m][n];
                        const f32x4 x1 = acc[ai][0][m][n], x2 = acc[ai][1][m][n];
                        o1[n] = (x1 * c4 - x2 * s4) * kr; o2[n] = (x2 * c4 + x1 * s4) * kr; }
                    *(u32x4*)rowp = pack8(o1[0], o1[1]); *(u32x4*)(rowp + 128) = pack8(o2[0], o2[1]); } }
        } else {
            const bool is_g = u.pn < 12;
#pragma unroll
            for (int ai = 0; ai < 2; ++ai)
#pragma unroll
                for (int m = 0; m < 4; ++m) { bf16_t* rowp = O + (size_t)(row0 + ai * 128 + m * 16) * 4096 + col0;
#pragma unroll
                    for (int bj = 0; bj < 2; ++bj) { f32x4 v0, v1; const float r = rv[ai][m], ir = __builtin_amdgcn_rcpf(r);
                        if (is_g) { const float c = r * -1.4426950408889634f; v0 = silu4r(acc[ai][bj][m][0], c, ir); v1 = silu4r(acc[ai][bj][m][1], c, ir); }
                        else { const float Ar = r * -2.3022082f, Br3 = r * r * r * -0.10294324f; v0 = gelu4r(acc[ai][bj][m][0], Ar, Br3, ir); v1 = gelu4r(acc[ai][bj][m][1], Ar, Br3, ir); }
                        *(u32x4*)(rowp + bj * 128) = pack8(v0, v1); } }
        }
    }
};
struct EpiInOdd {
    static constexpr bool PERM = true;
    bf16_t* O; const float* mcos; const float* msin; float* ksum; const float* rs;
    __device__ __forceinline__ void operator()(const AccT& acc, const pg8::Unit& u, int wr, int wc, int fr, int fq) const {
        const int row0 = u.pm * 256 + wr * 64 + fr, col0 = u.pn * 256 + wc * 32 + 8 * fq;
        const bool rot = (u.pn >= 4) && (wc == 0);
        const float sc = (u.pn >= 4 && u.pn < 8) ? QSCALE_MOBA : 1.f;
        f32x4 cs[2][2];
#pragma unroll
        for (int bj = 0; bj < 2; ++bj)
#pragma unroll
            for (int n = 0; n < 2; ++n) cs[bj][n] = (f32x4){0.f, 0.f, 0.f, 0.f};
#pragma unroll
        for (int ai = 0; ai < 2; ++ai)
#pragma unroll
          for (int mh = 0; mh < 2; ++mh) { f32x4 ctab[2][2], stab[2][2]; float rsv[2];
#pragma unroll
            for (int m2 = 0; m2 < 2; ++m2) rsv[m2] = ld_rs(rs, row0, ai * 128 + (2 * mh + m2) * 16);
            if (rot) {
#pragma unroll
                for (int m2 = 0; m2 < 2; ++m2)
#pragma unroll
                    for (int n = 0; n < 2; ++n) { const int tp = (row0 + ai * 128 + (2 * mh + m2) * 16) & (SEQ - 1), fi = (8 * fq + 4 * n) & 15; ctab[m2][n] = *(const f32x4*)(mcos + tp * 16 + fi); stab[m2][n] = *(const f32x4*)(msin + tp * 16 + fi); } }
#pragma unroll
            for (int m2 = 0; m2 < 2; ++m2) { const int m = 2 * mh + m2; const int row = row0 + ai * 128 + m * 16; bf16_t* rowp = O + (size_t)row * 3072 + col0; const float scr_ = sc * rsv[m2];
#pragma unroll
                for (int bj = 0; bj < 2; ++bj) { f32x4 v[2];
#pragma unroll
                    for (int n = 0; n < 2; ++n) { v[n] = acc[ai][bj][m][n];
                        if (rot) { f32x4 vp;
#pragma unroll
                            for (int j = 0; j < 4; ++j) vp[j] = __shfl_xor(v[n][j], 32);
                            const f32x4 c4 = ctab[m2][n], s4 = stab[m2][n];
                            v[n] = (fq < 2) ? (v[n] * c4 - vp * s4) : (v[n] * c4 + vp * s4); }
                        v[n] = v[n] * scr_; cs[bj][n] += v[n]; }
                    *(u32x4*)(rowp + bj * 128) = pack8(v[0], v[1]); } } }
        if (u.pn >= 8) {
#pragma unroll
            for (int bj = 0; bj < 2; ++bj)
#pragma unroll
                for (int n = 0; n < 2; ++n)
#pragma unroll
                    for (int j = 0; j < 4; ++j) { float s = cs[bj][n][j];
                        s += __shfl_xor(s, 1); s += __shfl_xor(s, 2); s += __shfl_xor(s, 4); s += __shfl_xor(s, 8);
                        if (fr == 0) atomicAdd(ksum + (size_t)u.pm * 1024 + (u.pn - 8) * 256 + bj * 128 + wc * 32 + 8 * fq + 4 * n + j, s); }
        }
    }
};
struct EpiPleGate {
    static constexpr bool PERM = true;
    bf16_t* O; const bf16_t* P; const float* rs;
    __device__ __forceinline__ void operator()(const AccT& acc, const pg8::Unit& u, int wr, int wc, int fr, int fq) const {
        const int row0 = u.pm * 256 + wr * 64 + fr, col0 = u.pn * 256 + wc * 32 + 8 * fq;
#pragma unroll
        for (int ai = 0; ai < 2; ++ai) { u32x4 pwv[4][2]; float rv[4];
#pragma unroll
            for (int m = 0; m < 4; ++m) rv[m] = ld_rs(rs, row0, ai * 128 + m * 16);
#pragma unroll
            for (int m = 0; m < 4; ++m)
#pragma unroll
                for (int bj = 0; bj < 2; ++bj) pwv[m][bj] = *(const u32x4*)(P + (size_t)(row0 + ai * 128 + m * 16) * D + col0 + bj * 128);
#pragma unroll
            for (int m = 0; m < 4; ++m) { const size_t off = (size_t)(row0 + ai * 128 + m * 16) * D + col0;
#pragma unroll
                for (int bj = 0; bj < 2; ++bj) { const u32x4 pw = pwv[m][bj]; const float c = rv[m] * -1.4426950408889634f;
                    const f32x4 v0 = sigmoid_mul4r(acc[ai][bj][m][0], c, bf_lo(pw.x), bf_hi(pw.x), bf_lo(pw.y), bf_hi(pw.y)), v1 = sigmoid_mul4r(acc[ai][bj][m][1], c, bf_lo(pw.z), bf_hi(pw.z), bf_lo(pw.w), bf_hi(pw.w));
                    *(u32x4*)(O + off + bj * 128) = pack8(v0, v1); } } }
    }
};

__device__ __forceinline__ int map_row(int mode, int n0) {
    if (mode == 1) return 256 * (n0 >> 7) + (n0 & 127);
    if (mode == 2) return 256 * (n0 >> 7) + 128 + (n0 & 127);
    if (mode == 3) { if (n0 < 2048) return n0; if (n0 < 3072) return n0 + 2048; if (n0 < 5120) return n0 - 1024; return n0; }
    return n0;
}
__device__ __forceinline__ void xpose_matrix(const float* W, int K, int N, bf16_t* WT, int mode, LAS float* scr, int gw, int NGW, int lane, const float* gain = nullptr) {
    const int nblk = N / 32, nitems = (K / 64) * nblk;
    for (int item = gw; item < nitems; item += NGW) {
        const int kb = item / nblk, nb = item % nblk, k0 = 64 * kb, n0 = 32 * nb, r0 = map_row(mode, n0);
#pragma unroll 8
        for (int i = 0; i < 32; ++i) { const int kk = 2 * i + (lane >> 5); scr[kk * 33 + (lane & 31)] = W[(size_t)(k0 + kk) * N + n0 + (lane & 31)]; }
        LDS_WAIT(); asm volatile("" ::: "memory");
        const int c = lane & 7;
        f32x4 g0 = (f32x4){1.f, 1.f, 1.f, 1.f}, g1 = g0;
        if (gain) { g0 = *(const f32x4*)(gain + k0 + 8 * c); g1 = *(const f32x4*)(gain + k0 + 8 * c + 4); }
#pragma unroll
        for (int j = 0; j < 4; ++j) { const int n = (lane >> 3) + 8 * j; const LAS float* s = scr + (8 * c) * 33 + n;
            u32x4 o; o.x = pk2(s[0 * 33] * g0[0], s[1 * 33] * g0[1]); o.y = pk2(s[2 * 33] * g0[2], s[3 * 33] * g0[3]); o.z = pk2(s[4 * 33] * g1[0], s[5 * 33] * g1[1]); o.w = pk2(s[6 * 33] * g1[2], s[7 * 33] * g1[3]);
            *(u32x4*)(WT + (size_t)(r0 + n) * K + k0 + 8 * c) = o; }
        LDS_WAIT(); asm volatile("" ::: "memory");
    }
}

__device__ __forceinline__ void xpose_matrix_f8(const float* W, int K, int N, unsigned char* WT, float scale, LAS float* scr, int gw, int NGW, int lane, int mode = 0, const float* gain = nullptr) {
    const int nblk = N / 32, nitems = (K / 64) * nblk;
    for (int item = gw; item < nitems; item += NGW) {
        const int kb = item / nblk, nb = item % nblk, k0 = 64 * kb, n0 = 32 * nb, r0 = map_row(mode, n0);
#pragma unroll 8
        for (int i = 0; i < 32; ++i) { const int kk = 2 * i + (lane >> 5); scr[kk * 33 + (lane & 31)] = W[(size_t)(k0 + kk) * N + n0 + (lane & 31)]; }
        LDS_WAIT(); asm volatile("" ::: "memory");
        const int c = lane & 7;
        f32x4 g0 = (f32x4){scale, scale, scale, scale}, g1 = g0;
        if (gain) { g0 = *(const f32x4*)(gain + k0 + 8 * c) * scale; g1 = *(const f32x4*)(gain + k0 + 8 * c + 4) * scale; }
#pragma unroll
        for (int j = 0; j < 4; ++j) { const int n = (lane >> 3) + 8 * j; const LAS float* s = scr + (8 * c) * 33 + n;
            u32x2 o; o.x = pack4_fp8((f32x4){s[0 * 33], s[1 * 33], s[2 * 33], s[3 * 33]} * g0); o.y = pack4_fp8((f32x4){s[4 * 33], s[5 * 33], s[6 * 33], s[7 * 33]} * g1);
            *(u32x2*)(WT + (size_t)(r0 + n) * K + k0 + 8 * c) = o; }
        LDS_WAIT(); asm volatile("" ::: "memory");
    }
}

template <bool HAS_T, bool XIN_F32 = true, bool XOUT_F32 = true>
__device__ __forceinline__ void rphase(const void* xin_, void* xout_, const bf16_t* T, float alpha, const float* gt, float* RS, int gw, int NGW, int lane, unsigned char* X8 = nullptr) {
    f32x4 gtv[8];
#pragma unroll
    for (int c = 0; c < 4; ++c) {
        if (HAS_T) { gtv[2 * c] = *(const f32x4*)(gt + 512 * c + 8 * lane); gtv[2 * c + 1] = *(const f32x4*)(gt + 512 * c + 8 * lane + 4); } }
    for (int row = gw; row < M; row += NGW) {
        f32x4 xv[8];
        if (XIN_F32) { const float* xr = (const float*)xin_ + (size_t)row * D + 8 * lane;
#pragma unroll
            for (int c = 0; c < 4; ++c) { xv[2 * c] = *(const f32x4*)(xr + 512 * c); xv[2 * c + 1] = *(const f32x4*)(xr + 512 * c + 4); }
        } else { const bf16_t* xr = (const bf16_t*)xin_ + (size_t)row * D + 8 * lane; u32x4 xw[4];
#pragma unroll
            for (int c = 0; c < 4; ++c) xw[c] = *(const u32x4*)(xr + 512 * c);
#pragma unroll
            for (int c = 0; c < 4; ++c) { xv[2 * c] = (f32x4){bf_lo(xw[c].x), bf_hi(xw[c].x), bf_lo(xw[c].y), bf_hi(xw[c].y)}; xv[2 * c + 1] = (f32x4){bf_lo(xw[c].z), bf_hi(xw[c].z), bf_lo(xw[c].w), bf_hi(xw[c].w)}; } }
        if (HAS_T) {
            u32x4 tv[4];
            const bf16_t* tr = T + (size_t)row * D + 8 * lane;
#pragma unroll
            for (int c = 0; c < 4; ++c) tv[c] = *(const u32x4*)(tr + 512 * c);
            f32x4 tf[8]; float ss = 0.f;
#pragma unroll
            for (int c = 0; c < 4; ++c) { tf[2 * c] = (f32x4){bf_lo(tv[c].x), bf_hi(tv[c].x), bf_lo(tv[c].y), bf_hi(tv[c].y)}; tf[2 * c + 1] = (f32x4){bf_lo(tv[c].z), bf_hi(tv[c].z), bf_lo(tv[c].w), bf_hi(tv[c].w)}; }
#pragma unroll
            for (int c = 0; c < 8; ++c) ss += (tf[c][0] * tf[c][0] + tf[c][1] * tf[c][1]) + (tf[c][2] * tf[c][2] + tf[c][3] * tf[c][3]);
            ss = wave_sum(ss);
            const float r = __builtin_amdgcn_rsqf(ss * (1.f / D) + EPS) * alpha;
#pragma unroll
            for (int c = 0; c < 4; ++c) { const f32x4 g0 = gtv[2 * c], g1 = gtv[2 * c + 1];
                xv[2 * c] += tf[2 * c] * g0 * r; xv[2 * c + 1] += tf[2 * c + 1] * g1 * r;
                if (XOUT_F32) { float* xo = (float*)xout_ + (size_t)row * D + 8 * lane; *(f32x4*)(xo + 512 * c) = xv[2 * c]; *(f32x4*)(xo + 512 * c + 4) = xv[2 * c + 1]; }
                else { bf16_t* xo = (bf16_t*)xout_ + (size_t)row * D + 8 * lane; *(u32x4*)(xo + 512 * c) = pack8(xv[2 * c], xv[2 * c + 1]); } }
        }
        if (!HAS_T) { bf16_t* xo = (bf16_t*)xout_ + (size_t)row * D + 8 * lane;
#pragma unroll
            for (int c = 0; c < 4; ++c) *(u32x4*)(xo + 512 * c) = pack8(xv[2 * c], xv[2 * c + 1]); }
        if (X8) { unsigned char* x8 = X8 + (size_t)row * D + 8 * lane;
#pragma unroll
            for (int c = 0; c < 4; ++c) { u32x2 w; w.x = pack4_fp8(xv[2 * c] * F8_XSCALE); w.y = pack4_fp8(xv[2 * c + 1] * F8_XSCALE); *(u32x2*)(x8 + 512 * c) = w; } }
        if (RS) {
            float s2 = 0.f;
#pragma unroll
            for (int c = 0; c < 8; ++c) s2 += (xv[c][0] * xv[c][0] + xv[c][1] * xv[c][1]) + (xv[c][2] * xv[c][2] + xv[c][3] * xv[c][3]);
            s2 = wave_sum(s2);
            if (lane == 0) RS[row] = __builtin_amdgcn_rsqf(s2 * (1.f / D) + EPS);
        }
    }
}

#define MFMA16(a, b, c) __builtin_amdgcn_mfma_f32_16x16x32_bf16((a), (b), (c), 0, 0, 0)

__device__ __forceinline__ void ret_tile(LAS unsigned char* lds, const bf16_t* Zn, const bf16_t* ZT, bf16_t* Y, int b, int h, int qt, int tid, int wid, int lane) {
    asm volatile("" : "+v"(tid), "+v"(lane));
    constexpr int KST = 544, VST = 144, OFF_V = 64 * KST, BUF = OFF_V + 256 * VST;
    const int r = lane & 15, q4 = lane >> 4;
    const int R0 = b * SEQ + qt * 128, t0w = qt * 128 + wid * 16;
    const float lg = __log2f(1.0f - exp2f(-5.0f - (float)h));
    bf16x8 qf[8];
    { const bf16_t* qrow = Zn + (size_t)(R0 + wid * 16 + r) * 4096 + h * 256 + q4 * 8;
#pragma unroll
      for (int kk = 0; kk < 8; ++kk) qf[kk] = *(const bf16x8*)(qrow + kk * 32); }
    f32x4 o[16];
#pragma unroll
    for (int e = 0; e < 16; ++e) o[e] = (f32x4){0.f, 0.f, 0.f, 0.f};
    const int nkt = 2 * (qt + 1);
    u32x4 pk[4], pv[4];
    const bf16_t* kbase = Zn + (size_t)(b * SEQ) * 4096 + 1024 + h * 256;
    const bf16_t* vbase = ZT + (size_t)(h * 256) * M + b * SEQ;
#define RET_PREFETCH(kt) do { _Pragma("unroll") for (int i = 0; i < 4; ++i) { const int c = tid + 512 * i; \
        pk[i] = *(const u32x4*)(kbase + (size_t)((kt) * 64 + (c >> 5)) * 4096 + (c & 31) * 8); \
        pv[i] = *(const u32x4*)(vbase + (size_t)(c >> 3) * M + (kt) * 64 + (c & 7) * 8); } } while (0)
#define RET_WRITE(bufp) do { _Pragma("unroll") for (int i = 0; i < 4; ++i) { const int c = tid + 512 * i; \
        *(LAS u32x4*)((bufp) + (c >> 5) * KST + (c & 31) * 16) = pk[i]; \
        *(LAS u32x4*)((bufp) + OFF_V + (c >> 3) * VST + (c & 7) * 16) = pv[i]; } } while (0)
    RET_PREFETCH(0);
    __syncthreads();
    RET_WRITE(lds);
    if (nkt > 1) RET_PREFETCH(1);
    for (int kt = 0; kt < nkt; ++kt) {
        __syncthreads();
        LAS unsigned char* cb = lds + (kt & 1) * BUF;
        if (kt + 1 < nkt) { LAS unsigned char* nb = lds + ((kt + 1) & 1) * BUF; RET_WRITE(nb); if (kt + 2 < nkt) RET_PREFETCH(kt + 2); }
        if (kt * 64 <= t0w + 15) {
            f32x4 sacc[4];
#pragma unroll
            for (int sb = 0; sb < 4; ++sb) sacc[sb] = (f32x4){0.f, 0.f, 0.f, 0.f};
#define RET_KF(dst, kk_) do { _Pragma("unroll") for (int sb = 0; sb < 4; ++sb) dst[sb] = *(const LAS bf16x8*)(cb + (16 * sb + r) * KST + (kk_) * 64 + q4 * 16); } while (0)
#define RET_VF(dst, eb_) do { _Pragma("unroll") for (int e2 = 0; e2 < 2; ++e2) _Pragma("unroll") for (int c = 0; c < 2; ++c) { const LAS unsigned char* vp = cb + OFF_V + (16 * ((eb_) + e2) + r) * VST + (32 * c + 4 * q4) * 2; \
                const s16x4 lo = *(const LAS s16x4*)vp, hi = *(const LAS s16x4*)(vp + 32); dst[e2][c] = __builtin_shufflevector(lo, hi, 0, 1, 2, 3, 4, 5, 6, 7); } } while (0)
            bf16x8 ka[4], kb[4], va[2][2], vb[2][2];
            RET_KF(ka, 0);
#pragma unroll
            for (int kk = 0; kk < 8; kk += 2) {
                RET_KF(kb, kk + 1); __builtin_amdgcn_sched_barrier(0);
{ __builtin_amdgcn_s_setprio(1);
#pragma unroll
for (int sb = 0; sb < 4; ++sb) sacc[sb] = MFMA16(ka[sb], qf[kk], sacc[sb]); __builtin_amdgcn_s_setprio(0); }
                __builtin_amdgcn_sched_barrier(0);
                if (kk + 2 < 8) RET_KF(ka, kk + 2); else RET_VF(va, 0);
                __builtin_amdgcn_sched_barrier(0);
{ __builtin_amdgcn_s_setprio(1);
#pragma unroll
for (int sb = 0; sb < 4; ++sb) sacc[sb] = MFMA16(kb[sb], qf[kk + 1], sacc[sb]); __builtin_amdgcn_s_setprio(0); }
                __builtin_amdgcn_sched_barrier(0);
            }
            const int dbase = t0w + r - (kt * 64 + 4 * q4);
#pragma unroll
            for (int sb = 0; sb < 4; ++sb)
#pragma unroll
                for (int i = 0; i < 4; ++i) { const int d = dbase - 16 * sb - i; const float w = __builtin_amdgcn_exp2f((float)d * lg); sacc[sb][i] = d >= 0 ? sacc[sb][i] * w : 0.f; }
            bf16x8 pf[2];
#pragma unroll
            for (int c = 0; c < 2; ++c) pf[c] = __builtin_bit_cast(bf16x8, pack8(sacc[2 * c], sacc[2 * c + 1]));
#pragma unroll
            for (int eb = 0; eb < 16; eb += 4) {
                RET_VF(vb, eb + 2); __builtin_amdgcn_sched_barrier(0); __builtin_amdgcn_s_setprio(1);
#pragma unroll
                for (int e2 = 0; e2 < 2; ++e2)
#pragma unroll
                    for (int c = 0; c < 2; ++c) o[eb + e2] = MFMA16(va[e2][c], pf[c], o[eb + e2]);
                __builtin_amdgcn_sched_barrier(0);
                __builtin_amdgcn_s_setprio(0); if (eb + 4 < 16) RET_VF(va, eb + 4);
                __builtin_amdgcn_sched_barrier(0); __builtin_amdgcn_s_setprio(1);
#pragma unroll
                for (int e2 = 0; e2 < 2; ++e2)
#pragma unroll
                    for (int c = 0; c < 2; ++c) o[eb + 2 + e2] = MFMA16(vb[e2][c], pf[c], o[eb + 2 + e2]);
                __builtin_amdgcn_s_setprio(0); __builtin_amdgcn_sched_barrier(0);
            }
#undef RET_KF
#undef RET_VF
        }
    }
#undef RET_PREFETCH
#undef RET_WRITE
    float ss = 0.f;
#pragma unroll
    for (int eb = 0; eb < 16; ++eb) ss += (o[eb][0] * o[eb][0] + o[eb][1] * o[eb][1]) + (o[eb][2] * o[eb][2] + o[eb][3] * o[eb][3]);
    ss += __shfl_xor(ss, 16); ss += __shfl_xor(ss, 32);
    const float rstd = __builtin_amdgcn_rsqf(ss * (1.f / 256.f) + EPS);
    const size_t row = (size_t)(R0 + wid * 16 + r);
    u32x2 gwv[16];
#pragma unroll
    for (int eb = 0; eb < 16; ++eb) gwv[eb] = *(const u32x2*)(Zn + row * 4096 + 2048 + h * 256 + 16 * eb + 4 * q4);
#pragma unroll
    for (int eb = 0; eb < 16; ++eb) { const int e = 16 * eb + 4 * q4;
        const u32x2 gw2 = gwv[eb];
        u32x2 w; w.x = pg8::cvt_pk_bf16(o[eb][0] * rstd * bf_lo(gw2.x), o[eb][1] * rstd * bf_hi(gw2.x)); w.y = pg8::cvt_pk_bf16(o[eb][2] * rstd * bf_lo(gw2.y), o[eb][3] * rstd * bf_hi(gw2.y));
        *(u32x2*)(Y + row * D + h * 256 + e) = w; }
}

__device__ __forceinline__ void sgu_unit(LAS unsigned char* lds, const bf16_t* Zn, const bf16_t* ZT, bf16_t* Y, const bf16_t* Wm  , const float* bias  , const float* gain  ,
                                         int b, int c, int g, int tid, int wid, int lane) {
    asm volatile("" : "+v"(tid), "+v"(lane));
    constexpr int WST = 272, VST = 272, OFF_W = 0, OFF_V = 128 * WST, OFF_P = OFF_V + 256 * VST, OFF_R = OFF_P + 8 * 64 * 8, OFF_GN = OFF_R + 512;
    const int r = lane & 15, q4 = lane >> 4;
    const int R0 = b * SEQ + c * 128;
    __syncthreads();
    { u32x4 sw_[4], sv_[8];
#pragma unroll
      for (int i = 0; i < 4; ++i) { const int ch = tid + 512 * i; sw_[i] = *(const u32x4*)(Wm + (size_t)g * 16384 + (ch >> 4) * 128 + (ch & 15) * 8); }
#pragma unroll
      for (int i = 0; i < 8; ++i) { const int ch = tid + 512 * i; sv_[i] = *(const u32x4*)(ZT + (size_t)(1024 + g * 256 + (ch >> 4)) * M + R0 + (ch & 15) * 8); }
      asm volatile("" :: "v"(sw_[0]), "v"(sw_[1]), "v"(sw_[2]), "v"(sw_[3]), "v"(sv_[0]), "v"(sv_[1]), "v"(sv_[2]), "v"(sv_[3]), "v"(sv_[4]), "v"(sv_[5]), "v"(sv_[6]), "v"(sv_[7]));
#pragma unroll
      for (int i = 0; i < 4; ++i) { const int ch = tid + 512 * i; *(LAS u32x4*)(lds + OFF_W + (ch >> 4) * WST + (ch & 15) * 16) = sw_[i]; }
#pragma unroll
      for (int i = 0; i < 8; ++i) { const int ch = tid + 512 * i; *(LAS u32x4*)(lds + OFF_V + (ch >> 4) * VST + (ch & 15) * 16) = sv_[i]; } }
    if (tid < 256) *(LAS float*)(lds + OFF_GN + tid * 4) = gain[g * 256 + tid];
    __syncthreads();
    { const int sp = tid & 63, part = tid >> 6; float a0 = 0.f, a1 = 0.f;
#pragma unroll 8
      for (int dd = 0; dd < 32; ++dd) { const unsigned w = *(const LAS unsigned*)(lds + OFF_V + (part * 32 + dd) * VST + sp * 4); const float v0 = bf_lo(w), v1 = bf_hi(w); a0 += v0 * v0; a1 += v1 * v1; }
      *(LAS f32x2*)(lds + OFF_P + (part * 64 + sp) * 8) = (f32x2){a0, a1}; }
    __syncthreads();
    if (tid < 64) { float a0 = 0.f, a1 = 0.f;
#pragma unroll
      for (int p = 0; p < 8; ++p) { const f32x2 v = *(const LAS f32x2*)(lds + OFF_P + (p * 64 + tid) * 8); a0 += v.x; a1 += v.y; }
      *(LAS f32x2*)(lds + OFF_R + tid * 8) = (f32x2){__builtin_amdgcn_rsqf(a0 * (1.f / 256.f) + EPS), __builtin_amdgcn_rsqf(a1 * (1.f / 256.f) + EPS)}; }
    __syncthreads();
    { const int sp = tid & 63, part = tid >> 6; const f32x2 rs = *(const LAS f32x2*)(lds + OFF_R + sp * 8);
#pragma unroll 8
      for (int dd = 0; dd < 32; ++dd) { const int d = part * 32 + dd; LAS unsigned* p = (LAS unsigned*)(lds + OFF_V + d * VST + sp * 4); const unsigned w = *p; const float gn = *(const LAS float*)(lds + OFF_GN + d * 4);
          *p = pg8::cvt_pk_bf16(bf_lo(w) * rs.x * gn, bf_hi(w) * rs.y * gn); } }
    __syncthreads();
    bf16x8 wf[4];
#pragma unroll
    for (int kk = 0; kk < 4; ++kk) wf[kk] = *(const LAS bf16x8*)(lds + OFF_W + (16 * wid + r) * WST + kk * 64 + q4 * 16);
    f32x4 acc[16];
#define SGU_VF(dst, db_) do { _Pragma("unroll") for (int kk = 0; kk < 4; ++kk) dst[kk] = *(const LAS bf16x8*)(lds + OFF_V + (16 * (db_) + r) * VST + kk * 64 + q4 * 16); } while (0)
    bf16x8 sva[4], svb[4];
    SGU_VF(sva, 0);
#pragma unroll
    for (int db = 0; db < 16; db += 2) {
        SGU_VF(svb, db + 1); __builtin_amdgcn_sched_barrier(0);
        acc[db] = (f32x4){0.f, 0.f, 0.f, 0.f};
#pragma unroll
        for (int kk = 0; kk < 4; ++kk) acc[db] = MFMA16(sva[kk], wf[kk], acc[db]);
        __builtin_amdgcn_sched_barrier(0);
        if (db + 2 < 16) SGU_VF(sva, db + 2);
        __builtin_amdgcn_sched_barrier(0);
        acc[db + 1] = (f32x4){0.f, 0.f, 0.f, 0.f};
#pragma unroll
        for (int kk = 0; kk < 4; ++kk) acc[db + 1] = MFMA16(svb[kk], wf[kk], acc[db + 1]);
        __builtin_amdgcn_sched_barrier(0);
    }
#undef SGU_VF
    const int t = 16 * wid + r; const float bs = bias[g * 128 + t];
    const size_t row = (size_t)(R0 + t);
    u32x2 uwv[16];
#pragma unroll
    for (int db = 0; db < 16; ++db) uwv[db] = *(const u32x2*)(Zn + row * 4096 + 3072 + g * 256 + 16 * db + 4 * q4);
#pragma unroll
    for (int db = 0; db < 16; ++db) { const int d = 16 * db + 4 * q4;
        const u32x2 uw = uwv[db];
        u32x2 w; w.x = pg8::cvt_pk_bf16((acc[db][0] + bs) * bf_lo(uw.x), (acc[db][1] + bs) * bf_hi(uw.x)); w.y = pg8::cvt_pk_bf16((acc[db][2] + bs) * bf_lo(uw.y), (acc[db][3] + bs) * bf_hi(uw.y));
        *(u32x2*)(Y + row * D + 1024 + g * 256 + d) = w; }
}

__device__ __forceinline__ void moba_tile(LAS unsigned char* lds, const bf16_t* Zn, const bf16_t* ZT, bf16_t* Y, const float* ksum, int b, int h, int qb, int tid, int wid, int lane) {
    asm volatile("" : "+v"(tid), "+v"(lane));
    constexpr int KST = 288, VST = 144, OFF_V = 64 * KST, BUF = OFF_V + 128 * VST, OFF_KS = 2 * BUF, OFF_G = OFF_KS + 4096, OFF_SEL = OFF_G + 8192;
    const int r = lane & 15, q4 = lane >> 4;
    const int R0 = b * SEQ + qb * 256, t0w = qb * 256 + wid * 32;
    const int nkt = 4 * (qb + 1);
    u32x4 pk[2], pv[2];
    const bf16_t* kbase = Zn + (size_t)(b * SEQ) * 3072 + 2048 + h * 128;
    const bf16_t* vbase = ZT + (size_t)(h * 128) * M + b * SEQ;
#define MOBA_PREFETCH(kt) do { _Pragma("unroll") for (int i = 0; i < 2; ++i) { const int c = tid + 512 * i; \
        pk[i] = *(const u32x4*)(kbase + (size_t)((kt) * 64 + (c >> 4)) * 3072 + (c & 15) * 8); \
        pv[i] = *(const u32x4*)(vbase + (size_t)(c >> 3) * M + (kt) * 64 + (c & 7) * 8); } } while (0)
#define MOBA_WRITE(bufp) do { _Pragma("unroll") for (int i = 0; i < 2; ++i) { const int c = tid + 512 * i; \
        *(LAS u32x4*)((bufp) + (c >> 4) * KST + (c & 15) * 16) = pk[i]; \
        *(LAS u32x4*)((bufp) + OFF_V + (c >> 3) * VST + (c & 7) * 16) = pv[i]; } } while (0)
    MOBA_PREFETCH(0);
    __syncthreads();
    unsigned mysel[2] = {(1u << qb) - 1u, (1u << qb) - 1u};
    if (qb >= 4) {
#pragma unroll
        for (int i = 0; i < 2; ++i) { const int e = tid + 512 * i; *(LAS float*)(lds + OFF_KS + e * 4) = ksum[(size_t)(b * 8 + (e >> 7)) * 1024 + h * 128 + (e & 127)]; }
        __syncthreads();
        { const int t = tid & 255, part = tid >> 8; const bf16_t* qrow = Zn + (size_t)(R0 + t) * 3072 + 1024 + h * 128;
          float g[4] = {0.f, 0.f, 0.f, 0.f};
          u32x4 qw_[16];
#pragma unroll
          for (int c = 0; c < 16; ++c) qw_[c] = *(const u32x4*)(qrow + 8 * c);
#pragma unroll
          for (int c = 0; c < 16; ++c) { const u32x4 w = qw_[c];
              const f32x4 ql = (f32x4){bf_lo(w.x), bf_hi(w.x), bf_lo(w.y), bf_hi(w.y)}, qh = (f32x4){bf_lo(w.z), bf_hi(w.z), bf_lo(w.w), bf_hi(w.w)};
#pragma unroll
              for (int i = 0; i < 4; ++i) { const LAS f32x4* kp = (const LAS f32x4*)(lds + OFF_KS + ((part + 2 * i) * 128 + 8 * c) * 4);
                  const f32x4 p = ql * kp[0] + qh * kp[1]; g[i] += (p[0] + p[1]) + (p[2] + p[3]); } }
#pragma unroll
          for (int i = 0; i < 4; ++i) *(LAS float*)(lds + OFF_G + (t * 8 + part + 2 * i) * 4) = g[i]; }
        __syncthreads();
        if (tid < 256) { float gv[8];
#pragma unroll
            for (int n = 0; n < 8; ++n) gv[n] = *(const LAS float*)(lds + OFF_G + (tid * 8 + n) * 4);
            unsigned bits = 0u;
#pragma unroll
            for (int n = 0; n < 8; ++n) { int rank = 0;
#pragma unroll
                for (int m2 = 0; m2 < 8; ++m2) rank += (m2 < qb && m2 != n && (gv[m2] > gv[n] || (gv[m2] == gv[n] && m2 < n))) ? 1 : 0;
                if (n < qb && rank < 3) bits |= 1u << n; }
            *(LAS unsigned*)(lds + OFF_SEL + tid * 4) = bits; }
        __syncthreads();
#pragma unroll
        for (int tb = 0; tb < 2; ++tb) mysel[tb] = *(const LAS unsigned*)(lds + OFF_SEL + (wid * 32 + 16 * tb + r) * 4);
    }
    MOBA_WRITE(lds);
    if (nkt > 1) MOBA_PREFETCH(1);
    bf16x8 qf[2][4];
#pragma unroll
    for (int tb = 0; tb < 2; ++tb) { const bf16_t* qrow = Zn + (size_t)(R0 + wid * 32 + 16 * tb + r) * 3072 + 1024 + h * 128 + q4 * 8;
#pragma unroll
      for (int kk = 0; kk < 4; ++kk) qf[tb][kk] = *(const bf16x8*)(qrow + kk * 32); }
    f32x4 o[2][8];
#pragma unroll
    for (int tb = 0; tb < 2; ++tb)
#pragma unroll
        for (int e = 0; e < 8; ++e) o[tb][e] = (f32x4){0.f, 0.f, 0.f, 0.f};
    float m_run[2] = {-1e30f, -1e30f}, l_run[2] = {0.f, 0.f};
    for (int kt = 0; kt < nkt; ++kt) {
        __syncthreads();
        LAS unsigned char* cb = lds + (kt & 1) * BUF;
        if (kt + 1 < nkt) { LAS unsigned char* nb = lds + ((kt + 1) & 1) * BUF; MOBA_WRITE(nb); if (kt + 2 < nkt) MOBA_PREFETCH(kt + 2); }
        const int nblk = kt >> 2; const bool own = (nblk == qb);
        if (!own || kt * 64 <= t0w + 31) {
            f32x4 sacc[2][4];
#pragma unroll
            for (int tb = 0; tb < 2; ++tb)
#pragma unroll
                for (int sb = 0; sb < 4; ++sb) sacc[tb][sb] = (f32x4){0.f, 0.f, 0.f, 0.f};
#define MOBA_KF(dst, kk_) do { _Pragma("unroll") for (int sb = 0; sb < 4; ++sb) dst[sb] = *(const LAS bf16x8*)(cb + (16 * sb + r) * KST + (kk_) * 64 + q4 * 16); } while (0)
#define MOBA_VF(dst, eb_) do { _Pragma("unroll") for (int e2 = 0; e2 < 2; ++e2) _Pragma("unroll") for (int c = 0; c < 2; ++c) { const LAS unsigned char* vp = cb + OFF_V + (16 * ((eb_) + e2) + r) * VST + (32 * c + 4 * q4) * 2; \
                const s16x4 lo = *(const LAS s16x4*)vp, hi = *(const LAS s16x4*)(vp + 32); dst[e2][c] = __builtin_shufflevector(lo, hi, 0, 1, 2, 3, 4, 5, 6, 7); } } while (0)
            bf16x8 ka[4], kb[4], va[2][2], vb[2][2];
            MOBA_KF(ka, 0);
#pragma unroll
            for (int kk = 0; kk < 4; kk += 2) {
                MOBA_KF(kb, kk + 1); __builtin_amdgcn_sched_barrier(0); __builtin_amdgcn_s_setprio(1);
#pragma unroll
                for (int sb = 0; sb < 4; ++sb) { sacc[0][sb] = MFMA16(ka[sb], qf[0][kk], sacc[0][sb]); sacc[1][sb] = MFMA16(ka[sb], qf[1][kk], sacc[1][sb]); }
                __builtin_amdgcn_s_setprio(0); __builtin_amdgcn_sched_barrier(0);
                if (kk + 2 < 4) MOBA_KF(ka, kk + 2); else MOBA_VF(va, 0);
                __builtin_amdgcn_sched_barrier(0); __builtin_amdgcn_s_setprio(1);
#pragma unroll
                for (int sb = 0; sb < 4; ++sb) { sacc[0][sb] = MFMA16(kb[sb], qf[0][kk + 1], sacc[0][sb]); sacc[1][sb] = MFMA16(kb[sb], qf[1][kk + 1], sacc[1][sb]); }
                __builtin_amdgcn_s_setprio(0); __builtin_amdgcn_sched_barrier(0);
            }
            bf16x8 pf[2][2];
#pragma unroll
            for (int tb = 0; tb < 2; ++tb) {
                const int t0b = t0w + 16 * tb;
                float mx = -1e30f;
                const bool diag = own && (kt * 64 + 63 > t0b);
                bool rowok = true;
                if (diag) { const int dbase = t0b + r - (kt * 64 + 4 * q4);
#pragma unroll
                    for (int sb = 0; sb < 4; ++sb)
#pragma unroll
                        for (int i = 0; i < 4; ++i) { sacc[tb][sb][i] = (dbase - 16 * sb - i >= 0) ? sacc[tb][sb][i] : -1e30f; mx = fmaxf(mx, sacc[tb][sb][i]); }
                } else { rowok = own || (((mysel[tb] >> nblk) & 1u) != 0u);
#pragma unroll
                    for (int sb = 0; sb < 4; ++sb) mx = fmaxf(fmaxf(mx, fmaxf(sacc[tb][sb][0], sacc[tb][sb][1])), fmaxf(sacc[tb][sb][2], sacc[tb][sb][3]));
                    mx = rowok ? mx : -1e30f; }
                mx = fmaxf(mx, __shfl_xor(mx, 16)); mx = fmaxf(mx, __shfl_xor(mx, 32));
                const float m_new = fmaxf(m_run[tb], mx);
                const float alpha = __builtin_amdgcn_exp2f(m_run[tb] - m_new);
                float ps = 0.f;
                if (diag) {
#pragma unroll
                    for (int sb = 0; sb < 4; ++sb)
#pragma unroll
                        for (int i = 0; i < 4; ++i) { const float p = sacc[tb][sb][i] > -1e29f ? __builtin_amdgcn_exp2f(sacc[tb][sb][i] - m_new) : 0.f; sacc[tb][sb][i] = p; ps += p; }
                } else { const float mm = rowok ? m_new : 1e30f;
#pragma unroll
                    for (int sb = 0; sb < 4; ++sb)
#pragma unroll
                        for (int i = 0; i < 4; ++i) { const float p = __builtin_amdgcn_exp2f(sacc[tb][sb][i] - mm); sacc[tb][sb][i] = p; ps += p; } }
                l_run[tb] = l_run[tb] * alpha + ps; m_run[tb] = m_new;
#pragma unroll
                for (int e = 0; e < 8; ++e) o[tb][e] = o[tb][e] * alpha;
#pragma unroll
                for (int c = 0; c < 2; ++c) pf[tb][c] = __builtin_bit_cast(bf16x8, pack8(sacc[tb][2 * c], sacc[tb][2 * c + 1]));
            }
#pragma unroll
            for (int eb = 0; eb < 8; eb += 4) {
                MOBA_VF(vb, eb + 2); __builtin_amdgcn_sched_barrier(0); __builtin_amdgcn_s_setprio(1);
#pragma unroll
                for (int e2 = 0; e2 < 2; ++e2)
#pragma unroll
                    for (int c = 0; c < 2; ++c) { o[0][eb + e2] = MFMA16(va[e2][c], pf[0][c], o[0][eb + e2]); o[1][eb + e2] = MFMA16(va[e2][c], pf[1][c], o[1][eb + e2]); }
                __builtin_amdgcn_s_setprio(0); if (eb + 4 < 8) MOBA_VF(va, eb + 4);
                __builtin_amdgcn_sched_barrier(0); __builtin_amdgcn_s_setprio(1);
#pragma unroll
                for (int e2 = 0; e2 < 2; ++e2)
#pragma unroll
                    for (int c = 0; c < 2; ++c) { o[0][eb + 2 + e2] = MFMA16(vb[e2][c], pf[0][c], o[0][eb + 2 + e2]); o[1][eb + 2 + e2] = MFMA16(vb[e2][c], pf[1][c], o[1][eb + 2 + e2]); }
                __builtin_amdgcn_s_setprio(0); __builtin_amdgcn_sched_barrier(0);
            }
#undef MOBA_KF
#undef MOBA_VF
        }
    }
#undef MOBA_PREFETCH
#undef MOBA_WRITE
#pragma unroll
    for (int tb = 0; tb < 2; ++tb) {
        float l = l_run[tb]; l += __shfl_xor(l, 16); l += __shfl_xor(l, 32);
        const float inv = 1.0f / l;
        const size_t row = (size_t)(R0 + wid * 32 + 16 * tb + r);
#pragma unroll
        for (int eb = 0; eb < 8; ++eb) { const int e = 16 * eb + 4 * q4;
            u32x2 w; w.x = pg8::cvt_pk_bf16(o[tb][eb][0] * inv, o[tb][eb][1] * inv); w.y = pg8::cvt_pk_bf16(o[tb][eb][2] * inv, o[tb][eb][3] * inv);
            *(u32x2*)(Y + row * D + 1024 + h * 128 + e) = w; } }
}

__device__ __forceinline__ void pool_unit(LAS unsigned char* lds, const bf16_t* Zn, bf16_t* Y, const bf16_t* Wt  , const float* scale  , int rt, int gi, int tid, int wid, int lane) {
    asm volatile("" : "+v"(tid), "+v"(lane));
    constexpr int AST = 544;
    const int r = lane & 15, q4 = lane >> 4;
    const int R0 = rt * 128, p0 = R0 & (SEQ - 1), win = 2 << gi;
    __syncthreads();
    { const int cc = tid & 31, tg = tid >> 5;
      const bf16_t* zb = Zn + (size_t)R0 * 3072 + gi * 256 + cc * 8;
      const int tfirst = tg * 8;
      u32x4 zr[23];
#pragma unroll
      for (int k = 0; k < 23; ++k) { int tt = tfirst - 15 + k; tt = (p0 + tt >= 0) ? tt : -p0; zr[k] = *(const u32x4*)(zb + (ptrdiff_t)tt * 3072); }
#pragma unroll
      for (int j8 = 0; j8 < 8; ++j8) { const int pos = p0 + tfirst + j8;
          f32x4 s0 = (f32x4){0.f, 0.f, 0.f, 0.f}, s1 = (f32x4){0.f, 0.f, 0.f, 0.f};
#pragma unroll
          for (int dt = 0; dt < 16; ++dt) { const u32x4 w = zr[15 + j8 - dt]; const float m = (dt < win && pos - dt >= 0) ? 1.f : 0.f;
              s0 += (f32x4){bf_lo(w.x), bf_hi(w.x), bf_lo(w.y), bf_hi(w.y)} * m; s1 += (f32x4){bf_lo(w.z), bf_hi(w.z), bf_lo(w.w), bf_hi(w.w)} * m; }
          const u32x4 w = zr[15 + j8]; const float ic = __builtin_amdgcn_rcpf((float)(pos + 1 < win ? pos + 1 : win));
          const f32x4 a = s0 * ic - (f32x4){bf_lo(w.x), bf_hi(w.x), bf_lo(w.y), bf_hi(w.y)}, bq = s1 * ic - (f32x4){bf_lo(w.z), bf_hi(w.z), bf_lo(w.w), bf_hi(w.w)};
          *(LAS u32x4*)(lds + (tfirst + j8) * AST + cc * 16) = pack8(a, bq); } }
    bf16x8 wf[2][8];
    { const bf16_t* wb = Wt + (size_t)gi * 65536 + (size_t)(32 * wid + r) * 256 + q4 * 8;
#pragma unroll
      for (int nbi = 0; nbi < 2; ++nbi)
#pragma unroll
          for (int kk = 0; kk < 8; ++kk) wf[nbi][kk] = *(const bf16x8*)(wb + (size_t)nbi * 16 * 256 + kk * 32); }
    __syncthreads();
    f32x4 sc[2];
#pragma unroll
    for (int nbi = 0; nbi < 2; ++nbi) sc[nbi] = *(const f32x4*)(scale + gi * 256 + 32 * wid + 16 * nbi + 4 * q4);
#define POOL_AF(dst, tb_) do { _Pragma("unroll") for (int kk = 0; kk < 8; ++kk) dst[kk] = *(const LAS bf16x8*)(lds + (16 * (tb_) + r) * AST + kk * 64 + q4 * 16); } while (0)
    bf16x8 afa[8], afb[8];
    POOL_AF(afa, 0);
#pragma unroll
    for (int tb = 0; tb < 8; ++tb) { f32x4 acc[2] = {(f32x4){0.f, 0.f, 0.f, 0.f}, (f32x4){0.f, 0.f, 0.f, 0.f}};
        if (tb + 1 < 8) { if (tb & 1) POOL_AF(afa, tb + 1); else POOL_AF(afb, tb + 1); }
        __builtin_amdgcn_sched_barrier(0);
#pragma unroll
        for (int kk = 0; kk < 8; ++kk) { const bf16x8 af = (tb & 1) ? afb[kk] : afa[kk];
            acc[0] = MFMA16(wf[0][kk], af, acc[0]); acc[1] = MFMA16(wf[1][kk], af, acc[1]); }
        __builtin_amdgcn_sched_barrier(0);
        const size_t row = (size_t)(R0 + 16 * tb + r);
#pragma unroll
        for (int nbi = 0; nbi < 2; ++nbi) { const int n = 32 * wid + 16 * nbi + 4 * q4;
            u32x2 w; w.x = pg8::cvt_pk_bf16(acc[nbi][0] * sc[nbi][0], acc[nbi][1] * sc[nbi][1]); w.y = pg8::cvt_pk_bf16(acc[nbi][2] * sc[nbi][2], acc[nbi][3] * sc[nbi][3]);
            *(u32x2*)(Y + row * D + gi * 256 + n) = w; } }
#undef POOL_AF
}

constexpr int NPH = 1 + 12 * DEPTH;
struct Args { const float* in[17]; float* out; unsigned char* ws; int ph_lo, ph_hi; };
typedef const __attribute__((address_space(4))) Args* ArgP;
__device__ __forceinline__ ArgP argp() { ArgP p = (ArgP)__builtin_amdgcn_kernarg_segment_ptr(); asm volatile("" : "+s"(p)); return p; }
#define PHASE_LOCALS() ArgP ap = argp(); unsigned char* const ws = ap->ws; int tid = threadIdx.x; asm volatile("" : "+v"(tid)); \
    int G_ = gridDim.x, bx_ = blockIdx.x; asm volatile("" : "+s"(G_), "+s"(bx_)); \
    const int lane = tid & 63, wid = __builtin_amdgcn_readfirstlane(tid >> 6), G = G_, bx = bx_, vcu = (G % 8 == 0) ? (bx % 8) * (G / 8) + bx / 8 : bx, gw = vcu * 8 + wid, NGW = G * 8; \
    (void)lane; (void)gw; (void)NGW; (void)ws
__global__ void __launch_bounds__(512, 2) mega_fwd(Args args_unused) {
    extern __shared__ __attribute__((aligned(16))) unsigned char lds_raw[];
    LAS unsigned char* lds = (LAS unsigned char*)lds_raw;
    volatile LAS unsigned* MISC = (volatile LAS unsigned*)(lds + MISC_OFF);
    for (int u = threadIdx.x; u < (LDS_BYTES - RING_BYTES) / 4; u += 512) ((LAS unsigned*)(lds + RING_BYTES))[u] = 0u;
    __syncthreads();
    int lo, hi; XcdBarrier bar;
    { ArgP ap = argp(); lo = ap->ph_lo; hi = ap->ph_hi; unsigned* ctl = (unsigned*)(ap->ws + WS_CTL);
      bar.bar = ctl + CW_BAR; bar.x = 0; bar.st = nullptr;
      if (hi - lo > 1) bar = xcd_barrier_post(ctl + CW_BAR, MISC + 8); }
#define IN(k) (lo <= (k) && (k) < hi)
#define SEAM(k) do { if (IN(k) && IN((k) + 1)) xcd_barrier(bar); } while (0)
#define P_T   ((bf16_t*)(ws + WS_T))
#define P_Y   ((bf16_t*)(ws + WS_Y))
#define P_BIG ((bf16_t*)(ws + WS_BIG))
#define P_ZT  ((bf16_t*)(ws + WS_BIG + 256 * MiB))
#define P_XB  ((bf16_t*)(ws + WS_H))
#define P_RS  ((float*)(ws + WS_RS))
#define P_X8  ((unsigned char*)(ws + WS_X8))

    if (IN(0)) {
        PHASE_LOCALS();
        LAS float* scr = (LAS float*)(lds + wid * 16384);
        for (int L = 0; L < DEPTH; ++L) {
            const int j = L >> 1;
            for (int f = 0; f < 2; ++f) {
                bf16_t* wgu = (bf16_t*)(ws + WS_WGU + (size_t)(L * 2 + f) * SZ_WGU);
                if (gu_f8(L, f)) { xpose_matrix_f8(ap->in[3] + (size_t)(L * 2 + f) * D * FF, D, FF, (unsigned char*)wgu, F8_WGSCALE, scr, gw, NGW, lane, 1, ap->in[2] + (size_t)(L * 8 + 4 * f) * D);
                                   xpose_matrix_f8(ap->in[4] + (size_t)(L * 2 + f) * D * FF, D, FF, (unsigned char*)wgu, F8_WGSCALE, scr, gw, NGW, lane, 2, ap->in[2] + (size_t)(L * 8 + 4 * f) * D); }
                else { xpose_matrix(ap->in[3] + (size_t)(L * 2 + f) * D * FF, D, FF, wgu, 1, scr, gw, NGW, lane, ap->in[2] + (size_t)(L * 8 + 4 * f) * D);
                       xpose_matrix(ap->in[4] + (size_t)(L * 2 + f) * D * FF, D, FF, wgu, 2, scr, gw, NGW, lane, ap->in[2] + (size_t)(L * 8 + 4 * f) * D); }
                if (dn_f8(L, f)) xpose_matrix_f8(ap->in[5] + (size_t)(L * 2 + f) * FF * D, FF, D, ws + WS_WDN + (size_t)(L * 2 + f) * SZ_WDN, F8_WSCALE, scr, gw, NGW, lane);
                else xpose_matrix(ap->in[5] + (size_t)(L * 2 + f) * FF * D, FF, D, (bf16_t*)(ws + WS_WDN + (size_t)(L * 2 + f) * SZ_WDN), 0, scr, gw, NGW, lane);
            }
            if ((L & 1) == 0) {
                xpose_matrix(ap->in[6] + (size_t)j * D * 6144, D, 6144, (bf16_t*)(ws + WS_WINE + (size_t)j * 6144 * D * 2), 3, scr, gw, NGW, lane, ap->in[2] + (size_t)(L * 8 + 2) * D);
                xpose_matrix(ap->in[7] + (size_t)j * D * D, D, D, (bf16_t*)(ws + WS_WOUT + (size_t)L * D * D * 2), 0, scr, gw, NGW, lane);
            } else {
                xpose_matrix(ap->in[11] + (size_t)j * D * 4096, D, 4096, (bf16_t*)(ws + WS_WINO + (size_t)j * 4096 * D * 2), 0, scr, gw, NGW, lane, ap->in[2] + (size_t)(L * 8 + 2) * D);
                xpose_matrix(ap->in[12] + (size_t)j * D * D, D, D, (bf16_t*)(ws + WS_WOUT + (size_t)L * D * D * 2), 0, scr, gw, NGW, lane);
                for (int g = 0; g < 4; ++g) xpose_matrix(ap->in[13] + (size_t)(j * 4 + g) * 65536, 256, 256, (bf16_t*)(ws + WS_POOLW) + (size_t)(j * 4 + g) * 65536, 0, scr, gw, NGW, lane);
            }
            xpose_matrix(ap->in[15] + (size_t)L * D * D, D, D, (bf16_t*)(ws + WS_WPG + (size_t)L * D * D * 2), 0, scr, gw, NGW, lane, ap->in[2] + (size_t)(L * 8 + 6) * D);
            xpose_matrix(ap->in[16] + (size_t)L * PLE * D, PLE, D, (bf16_t*)(ws + WS_WPP + (size_t)L * D * PLE * 2), 0, scr, gw, NGW, lane);
        }
        { const float* p_in = ap->in[1]; bf16_t* pb = (bf16_t*)(ws + WS_PBF); const size_t n8 = (size_t)DEPTH * M * PLE / 8;
          for (size_t i = (size_t)gw * 64 + lane; i < n8; i += (size_t)NGW * 64) { const f32x4 a = *(const f32x4*)(p_in + i * 8), b2 = *(const f32x4*)(p_in + i * 8 + 4); *(u32x4*)(pb + i * 8) = pack8(a, b2); } }
        { float* rc = (float*)(ws + WS_RCOS); float* rs = (float*)(ws + WS_RSIN); float* mc = (float*)(ws + WS_MCOS); float* ms = (float*)(ws + WS_MSIN);
          const int gt = gw * 64 + lane, NT = NGW * 64;
          for (int i = gt; i < SEQ * 128; i += NT) { const int t = i >> 7, f = i & 127; const float inv = 1.0f / powf(10000.0f, (float)f / 128.0f); const float ang = (float)t * inv;
              double rv = (double)ang * 0.15915494309189535; rv -= __builtin_rint(rv); rc[i] = __builtin_amdgcn_cosf((float)rv); rs[i] = __builtin_amdgcn_sinf((float)rv); }
          for (int i = gt; i < SEQ * 16; i += NT) { const int t = i >> 4, f = i & 15; const float inv = 1.0f / powf(500000.0f, (float)f / 16.0f); const float ang = (float)t * inv;
              double rv = (double)ang * 0.15915494309189535; rv -= __builtin_rint(rv); mc[i] = __builtin_amdgcn_cosf((float)rv); ms[i] = __builtin_amdgcn_sinf((float)rv); }
          const float* sgw = ap->in[8]; bf16_t* sw = (bf16_t*)(ws + WS_SGUW);
          for (int i = gt; i < 2 * 4 * 128 * 128; i += NT) { const int s = i & 127, t = (i >> 7) & 127; sw[i] = (bf16_t)f2bf(s <= t ? sgw[i] : 0.f); } }
        rphase<false, true, false>(ap->in[0], P_XB, nullptr, 0.f, nullptr, P_RS, gw, NGW, lane, gu_f8(0, 0) ? P_X8 : nullptr);
    }
    SEAM(0);

    for (int L = 0; L < DEPTH; ++L) {
        const int pb = 1 + 12 * L;
        if (IN(pb + 0)) { PHASE_LOCALS(); pg8::Gemm g{P_XB, (const bf16_t*)(ws + WS_WGU + (size_t)(L * 2) * SZ_WGU), M, 2 * FF, D}; pg8::StaticOrder S; S.init(M, 2 * FF, G, bx); if (gu_f8(L, 0)) { pg8::Gemm g8{(const bf16_t*)P_X8, g.Bt, M, 2 * FF, D / 2}; EpiGU8 E{(unsigned char*)P_BIG, P_RS, 1.f / (F8_XSCALE * F8_WGSCALE)}; pg8::gemm_phase<EpiGU8, pg8::StaticOrder, true, true, true>(lds, g8, S, E); }
            else if (dn_f8(L, 0)) { EpiGU8 E{(unsigned char*)P_BIG, P_RS, 1.f}; pg8::gemm_phase<EpiGU8, pg8::StaticOrder, true, true>(lds, g, S, E); }
            else { EpiGU E{P_BIG, P_RS}; pg8::gemm_phase<EpiGU, pg8::StaticOrder, true, true>(lds, g, S, E); } }
        SEAM(pb + 0);
        if (IN(pb + 1)) { PHASE_LOCALS(); pg8::StaticOrder S; S.init(M, D, G, bx);
            if (dn_f8(L, 0)) { pg8::Gemm g{P_BIG, (const bf16_t*)(ws + WS_WDN + (size_t)(L * 2) * SZ_WDN), M, D, FF / 2}; EpiPlainS E{P_T, D, 1.f / (F8_ASCALE * F8_WSCALE)};
                pg8::gemm_phase<EpiPlainS, pg8::StaticOrder, true, true, true>(lds, g, S, E); }
            else { pg8::Gemm g{P_BIG, (const bf16_t*)(ws + WS_WDN + (size_t)(L * 2) * SZ_WDN), M, D, FF}; EpiPlain E{P_T, D, 1 << 30};
                pg8::gemm_phase<EpiPlain, pg8::StaticOrder, true, true>(lds, g, S, E); } }
        SEAM(pb + 1);
        if (IN(pb + 2)) { PHASE_LOCALS(); const float* ng = ap->in[2] + (size_t)L * 8 * D; rphase<true, false, false>(P_XB, P_XB, P_T, 0.5f, ng + 1 * D, P_RS, gw, NGW, lane); }
        SEAM(pb + 2);
        if (IN(pb + 3)) {
            PHASE_LOCALS(); const int j = L >> 1;
            if ((L & 1) == 0) { const bf16_t* Win = (const bf16_t*)(ws + WS_WINE + (size_t)j * 6144 * D * 2);
                { pg8::Gemm g{P_XB, Win, M, 4096, D}; pg8::StaticOrder S; S.init(M, 4096, G, bx); EpiInEven E{P_BIG, (const float*)(ws + WS_RCOS), (const float*)(ws + WS_RSIN), P_RS};
                  pg8::gemm_phase<EpiInEven, pg8::StaticOrder, true, true>(lds, g, S, E); }
                { pg8::Gemm g{Win + (size_t)4096 * D, P_XB, 2048, M, D}; pg8::StaticOrder S; S.init(2048, M, G, bx); EpiPlainT E{P_ZT, M, 4, P_RS};
                  pg8::gemm_phase<EpiPlainT, pg8::StaticOrder, true, true>(lds, g, S, E); }
            } else { const bf16_t* Win = (const bf16_t*)(ws + WS_WINO + (size_t)j * 4096 * D * 2);
                { pg8::Gemm g{P_XB, Win, M, 3072, D}; pg8::StaticOrder S; S.init(M, 3072, G, bx); EpiInOdd E{P_BIG, (const float*)(ws + WS_MCOS), (const float*)(ws + WS_MSIN), (float*)(ws + WS_KSUM) + (size_t)j * 128 * 1024, P_RS};
                  pg8::gemm_phase<EpiInOdd, pg8::StaticOrder, true, true>(lds, g, S, E); }
                { pg8::Gemm g{Win + (size_t)3072 * D, P_XB, 1024, M, D}; pg8::StaticOrder S; S.init(1024, M, G, bx); EpiPlainT E{P_ZT, M, 1 << 30, P_RS};
                  pg8::gemm_phase<EpiPlainT, pg8::StaticOrder, true, true>(lds, g, S, E); }
            }
        }
        SEAM(pb + 3);
        if (IN(pb + 4)) {
            PHASE_LOCALS(); const int j = L >> 1;
            if ((L & 1) == 0) {
                const bf16_t* sw = (const bf16_t*)(ws + WS_SGUW) + (size_t)j * 4 * 16384;
                for (int u = bx; u < 512 + 1024; u += G) {
                    if (u < 512) { const int uix = ((u >> 3) & 31) + 32 * (u >> 8), bh = 8 * (u & 7) + (uix >> 3), pr = uix & 7;
                        ret_tile(lds, P_BIG, P_ZT, P_Y, bh >> 2, bh & 3, 15 - pr, tid, wid, lane);
                        ret_tile(lds, P_BIG, P_ZT, P_Y, bh >> 2, bh & 3, pr, tid, wid, lane);
                    } else { const int v = u - 512; sgu_unit(lds, P_BIG, P_ZT, P_Y, sw, ap->in[9] + (size_t)j * 512, ap->in[10] + (size_t)j * 1024, v >> 6, (v >> 2) & 15, v & 3, tid, wid, lane); }
                }
            } else {
                const float* ks = (const float*)(ws + WS_KSUM) + (size_t)j * 128 * 1024;
                const bf16_t* pw = (const bf16_t*)(ws + WS_POOLW) + (size_t)j * 4 * 65536;
                for (int u = bx; u < 512 + 1024; u += G) {
                    if (u < 512) { const int uix = ((u >> 3) & 31) + 32 * (u >> 8), bh = 16 * (u & 7) + (uix >> 2), pr = uix & 3;
                        moba_tile(lds, P_BIG, P_ZT, P_Y, ks, bh >> 3, bh & 7, 7 - pr, tid, wid, lane);
                        moba_tile(lds, P_BIG, P_ZT, P_Y, ks, bh >> 3, bh & 7, pr, tid, wid, lane);
                    } else { const int v = u - 512; pool_unit(lds, P_BIG, P_Y, pw, ap->in[14] + (size_t)j * 1024, v >> 2, v & 3, tid, wid, lane); }
                }
            }
        }
        SEAM(pb + 4);
        if (IN(pb + 5)) { PHASE_LOCALS(); pg8::Gemm g{P_Y, (const bf16_t*)(ws + WS_WOUT + (size_t)L * D * D * 2), M, D, D}; pg8::StaticOrder S; S.init(M, D, G, bx); EpiPlain E{P_T, D, 1 << 30};
            pg8::gemm_phase<EpiPlain, pg8::StaticOrder, true, true>(lds, g, S, E); }
        SEAM(pb + 5);
        if (IN(pb + 6)) { PHASE_LOCALS(); const float* ng = ap->in[2] + (size_t)L * 8 * D; rphase<true, false, false>(P_XB, P_XB, P_T, 1.0f, ng + 3 * D, P_RS, gw, NGW, lane, gu_f8(L, 1) ? P_X8 : nullptr); }
        SEAM(pb + 6);
        if (IN(pb + 7)) { PHASE_LOCALS(); pg8::Gemm g{P_XB, (const bf16_t*)(ws + WS_WGU + (size_t)(L * 2 + 1) * SZ_WGU), M, 2 * FF, D}; pg8::StaticOrder S; S.init(M, 2 * FF, G, bx); if (gu_f8(L, 1)) { pg8::Gemm g8{(const bf16_t*)P_X8, g.Bt, M, 2 * FF, D / 2}; EpiGU8 E{(unsigned char*)P_BIG, P_RS, 1.f / (F8_XSCALE * F8_WGSCALE)}; pg8::gemm_phase<EpiGU8, pg8::StaticOrder, true, true, true>(lds, g8, S, E); }
            else if (dn_f8(L, 1)) { EpiGU8 E{(unsigned char*)P_BIG, P_RS, 1.f}; pg8::gemm_phase<EpiGU8, pg8::StaticOrder, true, true>(lds, g, S, E); }
            else { EpiGU E{P_BIG, P_RS}; pg8::gemm_phase<EpiGU, pg8::StaticOrder, true, true>(lds, g, S, E); } }
        SEAM(pb + 7);
        if (IN(pb + 8)) {
            PHASE_LOCALS();
            if (dn_f8(L, 1)) { pg8::Gemm g{P_BIG, (const bf16_t*)(ws + WS_WDN + (size_t)(L * 2 + 1) * SZ_WDN), M, D, FF / 2}; pg8::StaticOrder S; S.init(M, D, G, bx); EpiPlainS E{P_T, D, 1.f / (F8_ASCALE * F8_WSCALE)};
              pg8::gemm_phase<EpiPlainS, pg8::StaticOrder, true, true, true>(lds, g, S, E); }
            else { pg8::Gemm g{P_BIG, (const bf16_t*)(ws + WS_WDN + (size_t)(L * 2 + 1) * SZ_WDN), M, D, FF}; pg8::StaticOrder S; S.init(M, D, G, bx); EpiPlain E{P_T, D, 1 << 30};
              pg8::gemm_phase<EpiPlain, pg8::StaticOrder, true, true>(lds, g, S, E); }
            { pg8::Gemm g{(const bf16_t*)(ws + WS_PBF) + (size_t)L * M * PLE, (const bf16_t*)(ws + WS_WPP + (size_t)L * D * PLE * 2), M, D, PLE}; pg8::StaticOrder S; S.init(M, D, G, bx); EpiPlain E{P_Y, D, 1 << 30};
              pg8::gemm_phase<EpiPlain, pg8::StaticOrder, true, true>(lds, g, S, E); }
        }
        SEAM(pb + 8);
        if (IN(pb + 9)) { PHASE_LOCALS(); const float* ng = ap->in[2] + (size_t)L * 8 * D; rphase<true, false, false>(P_XB, P_XB, P_T, 0.5f, ng + 5 * D, P_RS, gw, NGW, lane); }
        SEAM(pb + 9);
        if (IN(pb + 10)) { PHASE_LOCALS(); pg8::Gemm g{P_XB, (const bf16_t*)(ws + WS_WPG + (size_t)L * D * D * 2), M, D, D}; pg8::StaticOrder S; S.init(M, D, G, bx); EpiPleGate E{P_T, P_Y, P_RS};
            pg8::gemm_phase<EpiPleGate, pg8::StaticOrder, true, true>(lds, g, S, E); }
        SEAM(pb + 10);
        if (IN(pb + 11)) { PHASE_LOCALS(); const float* ng = ap->in[2] + (size_t)L * 8 * D; if (L + 1 < DEPTH) rphase<true, false, false>(P_XB, P_XB, P_T, 1.0f, ng + 7 * D, P_RS, gw, NGW, lane, gu_f8(L + 1, 0) ? P_X8 : nullptr);
            else rphase<true, false, true>(P_XB, ap->out, P_T, 1.0f, ng + 7 * D, nullptr, gw, NGW, lane); }
        SEAM(pb + 11);
    }
#undef IN
#undef SEAM
}

#ifndef MK_MULTI
#define MK_MULTI 0
#endif
extern "C" void kernel_launch(void* const* d_in, const int* in_sizes, int n_in, void* d_out, int out_size, void* d_ws, size_t ws_size, hipStream_t stream) {
    static int grid = 0;
    if (grid == 0) {
        if (n_in != 17 || in_sizes[0] != M * D || out_size != M * D || ws_size < WS_END) { fprintf(stderr, "kernel_launch: unexpected shapes (n_in %d, in0 %d, out %d, ws %zu < %zu)\n", n_in, n_in > 0 ? in_sizes[0] : -1, out_size, ws_size, (size_t)WS_END); grid = -1; return; }
        int dev = 0, cus = 0, per_cu = 0;
        if (hipGetDevice(&dev) != hipSuccess || hipDeviceGetAttribute(&cus, hipDeviceAttributeMultiprocessorCount, dev) != hipSuccess) { grid = -1; return; }
        if (hipFuncSetAttribute((const void*)mega_fwd, hipFuncAttributeMaxDynamicSharedMemorySize, LDS_BYTES) != hipSuccess) { fprintf(stderr, "kernel_launch: hipFuncSetAttribute failed\n"); grid = -1; return; }
        if (hipOccupancyMaxActiveBlocksPerMultiprocessor(&per_cu, (const void*)mega_fwd, 512, LDS_BYTES) != hipSuccess || per_cu < 1) { fprintf(stderr, "kernel_launch: occupancy query reports %d\n", per_cu); }
        (void)hipGetLastError();
        grid = cus;
    }
    if (grid < 0) return;
    (void)hipMemsetAsync((char*)d_ws + WS_CTL, 0, CTL_ZERO_BYTES, stream);
    Args a{};
    for (int i = 0; i < 17; ++i) a.in[i] = (const float*)d_in[i];
    a.out = (float*)d_out; a.ws = (unsigned char*)d_ws;
#if MK_MULTI
    for (int p = 0; p < NPH; ++p) { a.ph_lo = p; a.ph_hi = p + 1; hipLaunchKernelGGL(mega_fwd, dim3(grid), dim3(512), LDS_BYTES, stream, a); }
#else
    a.ph_lo = 0; a.ph_hi = NPH;
    hipLaunchKernelGGL(mega_fwd, dim3(grid), dim3(512), LDS_BYTES, stream, a);
#endif
    const hipError_t le = hipPeekAtLastError();
    if (le != hipSuccess) fprintf(stderr, "kernel_launch: launch failed: %s\n", hipGetErrorName(le));
}
```

```cpp
#include <hip/hip_runtime.h>
#include <cstdio>
#include <cstdint>

#define LAS __attribute__((address_space(3)))
typedef unsigned short bf16_t;
typedef short bf16x8 __attribute__((ext_vector_type(8)));
typedef short s16x4 __attribute__((ext_vector_type(4)));
typedef float f32x4 __attribute__((ext_vector_type(4)));
typedef float f32x2 __attribute__((ext_vector_type(2)));
typedef unsigned u32x4 __attribute__((ext_vector_type(4)));
typedef unsigned u32x2 __attribute__((ext_vector_type(2)));

namespace pg8 {
constexpr int BM = 256, BK = 64, HALF = 128, HTB = HALF * BK * 2, STAGE_BYTES = 8 * HTB, NXCD = 8, WGM = 8;
__host__ __device__ __forceinline__ int lds_byte(int r, int c) { const int st = (r >> 4) * 2 + (c >> 5), rr = r & 15, cc = c & 31, ob = rr * 64 + cc * 2; return st * 1024 + (ob ^ (((ob >> 9) & 1) << 5)); }
__host__ __device__ __forceinline__ void stage_rc(int b, int& R, int& C) { const int st = b / 1024, sb = b % 1024, swz = sb ^ (((sb >> 9) & 1) << 5); R = (st >> 1) * 16 + swz / 64; C = (st & 1) * 32 + (swz % 64) / 2; }
__host__ __device__ __forceinline__ int perm32(int rho) { const int n = rho >> 4, i = rho & 15; return 8 * (i >> 2) + 4 * n + (i & 3); }
struct Unit { int pm, pn; };
struct Gemm { const bf16_t* A; const bf16_t* Bt; int M, N, K; };
struct StaticOrder {
    int nM, nN, nwg, G, c;
    __host__ __device__ void init(int M, int N, int G_, int c_) { nM = M / BM; nN = N / BM; nwg = nM * nN; G = G_; c = c_; }
    __host__ __device__ bool next(int i, Unit& u) const {
        const long L = (long)i * G + c; if (L >= nwg) return false;
        int wgid = (int)L; { const int q = nwg / NXCD, r = nwg % NXCD, xcd = wgid % NXCD, off = wgid / NXCD; wgid = (xcd < r ? xcd * (q + 1) : r * (q + 1) + (xcd - r) * q) + off; }
        const int nig = WGM * nN, gid = wgid / nig, fm = gid * WGM, gsz = (nM - fm) < WGM ? (nM - fm) : WGM;
        u.pm = fm + ((wgid % nig) % gsz); u.pn = (wgid % nig) / gsz; return true;
    }
    __device__ __forceinline__ void a_ready(const Unit&) const {}
    __device__ __forceinline__ void done(const Unit&) const {}
};
__device__ __forceinline__ unsigned cvt_pk_bf16(float lo, float hi) { unsigned r; asm volatile("v_cvt_pk_bf16_f32 %0, %1, %2" : "=v"(r) : "v"(lo), "v"(hi)); return r; }

typedef int i32x4 __attribute__((ext_vector_type(4)));
typedef int i32x8 __attribute__((ext_vector_type(8)));
template <bool F8>
__device__ __forceinline__ void mma_blk(f32x4 (&c)[4][2], const bf16x8 (&At)[4][2], const bf16x8 (&Bt)[2][2]) {
    __builtin_amdgcn_s_setprio(1);
    if constexpr (F8) {
#pragma unroll
        for (int m = 0; m < 4; ++m)
#pragma unroll
            for (int n = 0; n < 2; ++n) {
                const i32x8 b8 = __builtin_shufflevector(__builtin_bit_cast(i32x4, Bt[n][0]), __builtin_bit_cast(i32x4, Bt[n][1]), 0, 1, 2, 3, 4, 5, 6, 7);
                const i32x8 a8 = __builtin_shufflevector(__builtin_bit_cast(i32x4, At[m][0]), __builtin_bit_cast(i32x4, At[m][1]), 0, 1, 2, 3, 4, 5, 6, 7);
                c[m][n] = __builtin_amdgcn_mfma_scale_f32_16x16x128_f8f6f4(b8, a8, c[m][n], 0, 0, 0, 0, 0, 0); }
    } else {
#pragma unroll
        for (int m = 0; m < 4; ++m)
#pragma unroll
            for (int n = 0; n < 2; ++n)
#pragma unroll
                for (int k = 0; k < 2; ++k) c[m][n] = __builtin_amdgcn_mfma_f32_16x16x32_bf16(Bt[n][k], At[m][k], c[m][n], 0, 0, 0);
    }
    __builtin_amdgcn_s_setprio(0);
}
template <class Epi, class Sched, bool ALIGN_EPI = false, bool SP2 = false, bool F8 = false>
__device__ __forceinline__ void gemm_phase(LAS unsigned char* lds, const Gemm g, const Sched& S, const Epi& E) {
    int tid_ = threadIdx.x; asm volatile("" : "+v"(tid_));
    const int tid = tid_, wid = __builtin_amdgcn_readfirstlane(tid >> 6), lane = tid & 63, wr = wid >> 2, wc = wid & 3, fr = lane & 15, fq = lane >> 4;
    const int K = g.K, nt = K / BK;
    unsigned voffA, voffB;
    { int R, C; stage_rc(tid * 16, R, C); const int Rb = Epi::PERM ? ((R & ~31) + perm32(R & 31)) : R;
      voffA = (unsigned)(R * K + C) * 2u; voffB = (unsigned)(Rb * K + C) * 2u; }
    const size_t rstep = (size_t)64 * K * 2;
    const size_t kstep = (size_t)(BK * 2);
    const size_t hstep = (size_t)HALF * K * 2;
    const size_t tstep = 2 * hstep;
    const unsigned ldsw = (unsigned)wid * 1024u;
    const int aoff = lds_byte(wr * 64 + fr, fq * 8), boff = lds_byte(wc * 32 + fr, fq * 8);
#define PG8_SA(b, h) (((b) * 2 + (h)) * HTB)
#define PG8_SB(b, h) ((4 + (b) * 2 + (h)) * HTB)
#define PG8_STAGE(bufoff, gbase, voff) do { _Pragma("unroll") for (int _i = 0; _i < 2; ++_i) { if constexpr (F8) asm volatile("" : "+v"(voff));     \
        __builtin_amdgcn_global_load_lds((const unsigned*)((const char*)(gbase) + _i * rstep + (voff)), (LAS unsigned*)(lds + (bufoff) + ldsw + _i * 8192), 16, 0, 0); } } while (0)
#define PG8_LDA(dst, b, h) do { _Pragma("unroll") for (int m = 0; m < 4; ++m) _Pragma("unroll") for (int k = 0; k < 2; ++k) dst[m][k] = *(const LAS bf16x8*)(lds + PG8_SA(b, h) + aoff + m * 2048 + k * 1024); } while (0)
#define PG8_LDB(dst, b, h) do { _Pragma("unroll") for (int n = 0; n < 2; ++n) _Pragma("unroll") for (int k = 0; k < 2; ++k) dst[n][k] = *(const LAS bf16x8*)(lds + PG8_SB(b, h) + boff + n * 2048 + k * 1024); } while (0)
#define PG8_MMA(ai, bj, At, Bt) mma_blk<F8>(acc[ai][bj], At, Bt)
#define PG8_WAIT_V(n) asm volatile("s_waitcnt vmcnt(" #n ")" ::: "memory")
#define PG8_WAIT_L(n) asm volatile("s_waitcnt lgkmcnt(" #n ")" ::: "memory")
#define PG8_BAR __builtin_amdgcn_s_barrier()
#define PG8_SCHED __builtin_amdgcn_sched_barrier(0)
    Unit cur, nxt; int ui = 0;
    if (!S.next(0, cur)) return;
    f32x4 acc[2][2][4][2];
#pragma unroll
    for (int a = 0; a < 2; ++a)
#pragma unroll
        for (int b = 0; b < 2; ++b)
#pragma unroll
            for (int m = 0; m < 4; ++m)
#pragma unroll
                for (int n = 0; n < 2; ++n) acc[a][b][m][n] = (f32x4){0.f, 0.f, 0.f, 0.f};
    bf16x8 At[4][2], B0[2][2], B1[2][2];
    const char* cA = (const char*)g.A + (size_t)cur.pm * tstep; const char* cB = (const char*)g.Bt + (size_t)cur.pn * tstep;
    S.a_ready(cur);
    if constexpr (SP2) {
        PG8_STAGE(PG8_SB(0, 0), cB, voffB); PG8_STAGE(PG8_SB(0, 1), cB + hstep, voffB); PG8_STAGE(PG8_SA(0, 0), cA, voffA); PG8_STAGE(PG8_SA(0, 1), cA + hstep, voffA);
        if (wr == 1) PG8_BAR;
        PG8_WAIT_V(2); PG8_BAR;
        PG8_STAGE(PG8_SB(1, 0), cB + kstep, voffB); PG8_STAGE(PG8_SA(1, 0), cA + kstep, voffA); PG8_STAGE(PG8_SB(1, 1), cB + hstep + kstep, voffB);
        PG8_WAIT_V(6); PG8_BAR;
    } else {
        PG8_STAGE(PG8_SB(0, 0), cB, voffB); PG8_STAGE(PG8_SA(0, 0), cA, voffA); PG8_STAGE(PG8_SB(0, 1), cB + hstep, voffB); PG8_STAGE(PG8_SA(0, 1), cA + hstep, voffA);
        if (wr == 1) PG8_BAR;
        PG8_WAIT_V(4); PG8_BAR;
        PG8_STAGE(PG8_SB(1, 0), cB + kstep, voffB); PG8_STAGE(PG8_SA(1, 0), cA + kstep, voffA); PG8_STAGE(PG8_SB(1, 1), cB + hstep + kstep, voffB);
        PG8_WAIT_V(6); PG8_BAR;
    }
    for (;;) {
        const bool has_next = S.next(ui + 1, nxt);
        const char* nA = has_next ? (const char*)g.A + (size_t)nxt.pm * tstep : cA; const char* nB = has_next ? (const char*)g.Bt + (size_t)nxt.pn * tstep : cB;
        for (int t = 0; t < nt; t += 2) {
            const bool last = (t == nt - 2);
            const char* a1 = cA + (size_t)(t + 1) * kstep;
            const char* a2 = last ? nA : cA + (size_t)(t + 2) * kstep; const char* b2 = last ? nB : cB + (size_t)(t + 2) * kstep;
            const char* a3 = a2 + kstep; const char* b3 = b2 + kstep;
            if (last && has_next) S.a_ready(nxt);
            if constexpr (SP2) {
            PG8_LDB(B0, 0, 0); PG8_LDB(B1, 0, 1); PG8_SCHED; PG8_LDA(At, 0, 0); PG8_STAGE(PG8_SA(1, 1), a1 + hstep, voffA);
            PG8_WAIT_V(8); PG8_WAIT_L(0); PG8_BAR; PG8_MMA(0, 0, At, B0); PG8_MMA(0, 1, At, B1); PG8_BAR; PG8_SCHED;
            PG8_LDA(At, 0, 1); PG8_STAGE(PG8_SB(0, 0), b2, voffB); PG8_STAGE(PG8_SB(0, 1), b2 + hstep, voffB); PG8_STAGE(PG8_SA(0, 0), a2, voffA);
            PG8_WAIT_V(8); PG8_WAIT_L(0); PG8_BAR; PG8_MMA(1, 0, At, B0); PG8_MMA(1, 1, At, B1); PG8_BAR; PG8_SCHED;
            PG8_LDB(B0, 1, 0); PG8_LDB(B1, 1, 1); PG8_SCHED; PG8_LDA(At, 1, 0); PG8_STAGE(PG8_SA(0, 1), a2 + hstep, voffA);
            PG8_WAIT_V(8); PG8_WAIT_L(0); PG8_BAR; PG8_MMA(0, 0, At, B0); PG8_MMA(0, 1, At, B1); PG8_BAR; PG8_SCHED;
            PG8_LDA(At, 1, 1); PG8_STAGE(PG8_SB(1, 0), b3, voffB); PG8_STAGE(PG8_SB(1, 1), b3 + hstep, voffB); PG8_STAGE(PG8_SA(1, 0), a3, voffA);
            PG8_WAIT_V(8); PG8_WAIT_L(0); PG8_BAR; PG8_MMA(1, 0, At, B0); PG8_MMA(1, 1, At, B1); PG8_BAR; PG8_SCHED;
            } else {
            PG8_LDB(B0, 0, 0); PG8_SCHED; PG8_LDA(At, 0, 0); PG8_STAGE(PG8_SA(1, 1), a1 + hstep, voffA);
            PG8_WAIT_L(8); PG8_BAR; PG8_WAIT_L(0); PG8_MMA(0, 0, At, B0); PG8_BAR; PG8_SCHED;
            PG8_LDB(B1, 0, 1); PG8_STAGE(PG8_SB(0, 0), b2, voffB);
            PG8_BAR; PG8_WAIT_L(0); PG8_MMA(0, 1, At, B1); PG8_BAR;
            PG8_LDA(At, 0, 1); PG8_STAGE(PG8_SA(0, 0), a2, voffA);
            PG8_BAR; PG8_WAIT_L(0); PG8_MMA(1, 0, At, B0); PG8_BAR; PG8_SCHED;
            PG8_STAGE(PG8_SB(0, 1), b2 + hstep, voffB);
            PG8_WAIT_V(6); PG8_BAR; PG8_MMA(1, 1, At, B1); PG8_BAR;
            PG8_LDB(B0, 1, 0); PG8_SCHED; PG8_LDA(At, 1, 0); PG8_STAGE(PG8_SA(0, 1), a2 + hstep, voffA);
            PG8_WAIT_L(8); PG8_BAR; PG8_WAIT_L(0); PG8_MMA(0, 0, At, B0); PG8_BAR; PG8_SCHED;
            PG8_LDB(B1, 1, 1); PG8_STAGE(PG8_SB(1, 0), b3, voffB);
            PG8_BAR; PG8_WAIT_L(0); PG8_MMA(0, 1, At, B1); PG8_BAR;
            PG8_LDA(At, 1, 1); PG8_STAGE(PG8_SA(1, 0), a3, voffA);
            PG8_BAR; PG8_WAIT_L(0); PG8_MMA(1, 0, At, B0); PG8_BAR; PG8_SCHED;
            PG8_STAGE(PG8_SB(1, 1), b3 + hstep, voffB);
            PG8_WAIT_V(6); PG8_BAR; PG8_MMA(1, 1, At, B1); PG8_BAR;
            }
        }
        if constexpr (ALIGN_EPI) { if (wr == 0) PG8_BAR; }
        { const int ln = __builtin_amdgcn_mbcnt_hi(~0u, __builtin_amdgcn_mbcnt_lo(~0u, 0u));
          E(acc, cur, wr, wc, ln & 15, ln >> 4); } S.done(cur);
        if (!has_next) break;
#pragma unroll
        for (int a = 0; a < 2; ++a)
#pragma unroll
            for (int b = 0; b < 2; ++b)
#pragma unroll
                for (int m = 0; m < 4; ++m)
#pragma unroll
                    for (int n = 0; n < 2; ++n) acc[a][b][m][n] = (f32x4){0.f, 0.f, 0.f, 0.f};
        cur = nxt; cA = nA; cB = nB; ++ui;
        if constexpr (ALIGN_EPI) { if (wr == 1) PG8_BAR; }
    }
    PG8_WAIT_V(0);
    if constexpr (!ALIGN_EPI) { if (wr == 0) PG8_BAR; }
    PG8_BAR;
#undef PG8_SA
#undef PG8_SB
#undef PG8_STAGE
#undef PG8_LDA
#undef PG8_LDB
#undef PG8_MMA
#undef PG8_WAIT_V
#undef PG8_WAIT_L
#undef PG8_BAR
#undef PG8_SCHED
}
}

constexpr int NB = 16, SEQ = 2048, D = 2048, M = NB * SEQ, FF = 5632, DEPTH = 4, PLE = 256;
constexpr float EPS = 1e-6f;
constexpr float QSCALE_MOBA = 0.08838834764831845f * 1.4426950408889634f;

constexpr size_t MiB = 1u << 20;
constexpr size_t WS_CTL = 0, WS_KSUM = 1 * MiB, CTL_ZERO_BYTES = 2 * MiB;
constexpr size_t WS_RCOS = 2 * MiB, WS_RSIN = 3 * MiB, WS_MCOS = 4 * MiB, WS_MSIN = 4 * MiB + 128 * 1024;
constexpr size_t WS_SGUW = 5 * MiB, WS_POOLW = 6 * MiB, WS_RS = 7 * MiB;
constexpr size_t WS_WGU = 8 * MiB, WS_WDN = 360 * MiB, WS_WINE = 536 * MiB, WS_WINO = 584 * MiB, WS_WOUT = 616 * MiB, WS_WPG = 648 * MiB, WS_WPP = 680 * MiB;
constexpr size_t WS_PBF = 684 * MiB, WS_H = 748 * MiB, WS_T = 876 * MiB, WS_Y = 1004 * MiB, WS_BIG = 1132 * MiB, WS_X8 = 1516 * MiB, WS_END = 1580 * MiB;
constexpr size_t SZ_WGU = (size_t)2 * FF * D * 2, SZ_WDN = (size_t)D * FF * 2;
constexpr int CW_BAR = 4096;

constexpr int RING_BYTES = 131072, LDS_BYTES = 147456, MISC_OFF = LDS_BYTES - 64;

#define XB_TMO      128
#define XB_XCNT(j)  (256  + 64 * (j))
#define XB_XSUB(j)  (1280 + 64 * (j))
#define XB_XGEN(j)  (2304 + 64 * (j))
#define XB_TOP      3328
#define XB_TOPGEN   3392
#define XCD_BAR_WORDS 3456
#define XB_SPIN_CAP (1u << 18)
__device__ __forceinline__ unsigned xb_ld(unsigned* p)              { return __hip_atomic_load(p, __ATOMIC_RELAXED, __HIP_MEMORY_SCOPE_AGENT); }
__device__ __forceinline__ unsigned xb_add(unsigned* p, unsigned v) { return __hip_atomic_fetch_add(p, v, __ATOMIC_RELAXED, __HIP_MEMORY_SCOPE_AGENT); }
__device__ __forceinline__ unsigned xb_xcc_id() { return (unsigned)__builtin_amdgcn_s_getreg((3 << 11) | 20) & 0xFu; }
#define XB_SPIN(cond, bar) do { unsigned _sp = 0; while (cond) { __builtin_amdgcn_s_sleep(1); \
    if ((++_sp & 255u) == 0u) { if (xb_ld(&(bar)[XB_TMO])) break; if (_sp > XB_SPIN_CAP) { atomicAdd(&(bar)[XB_TMO], 1u); break; } } } } while (0)
struct XcdBarrier { unsigned* bar; unsigned x; volatile LAS unsigned* st; };
__device__ __forceinline__ XcdBarrier xcd_barrier_post(unsigned* bar, volatile LAS unsigned* st) {
    XcdBarrier b; b.bar = bar; b.x = xb_xcc_id(); b.st = st;
    if (threadIdx.x == 0) (void)xb_add(&bar[XB_XCNT(b.x)], 1u);
    return b;
}
__device__ __forceinline__ void xcd_barrier_complete(unsigned* bar, unsigned x, unsigned& nloc, unsigned& nx) {
    const unsigned G = gridDim.x * gridDim.y * gridDim.z;
    unsigned sum, cnt, mine, sp = 0u;
    for (;;) {
        sum = 0u; cnt = 0u; mine = 0u;
#pragma unroll
        for (unsigned j = 0; j < 16; ++j) { const unsigned c = xb_ld(&bar[XB_XCNT(j)]); sum += c; cnt += (c > 0u) ? 1u : 0u; mine = (j == x) ? c : mine; }
        if (sum == G) break;
        __builtin_amdgcn_s_sleep(1);
        if ((++sp & 255u) == 0u) { if (xb_ld(&bar[XB_TMO])) break; if (sp > XB_SPIN_CAP) { atomicAdd(&bar[XB_TMO], 1u); break; } }
    }
    nloc = mine > 0u ? mine : 1u; nx = cnt > 0u ? cnt : 1u;
}
__device__ __forceinline__ void xcd_barrier(const XcdBarrier& b) {
    asm volatile("s_waitcnt vmcnt(0)" ::: "memory");
    __syncthreads();
    if (threadIdx.x == 0) {
        unsigned* bar = b.bar;
        __builtin_amdgcn_s_waitcnt(0);
        unsigned nloc = b.st[0], nx = b.st[1];
        if (nloc == 0u) { xcd_barrier_complete(bar, b.x, nloc, nx); b.st[0] = nloc; b.st[1] = nx; }
        const unsigned old = xb_add(&bar[XB_XSUB(b.x)], 1u);
        const unsigned gen = old / nloc;
        if (old + 1u == (gen + 1u) * nloc) {
            __builtin_amdgcn_fence(__ATOMIC_RELEASE, "agent");
            asm volatile("s_waitcnt vmcnt(0)" ::: "memory");
            const unsigned og = xb_add(&bar[XB_TOP], 1u);
            const unsigned tg = og / nx;
            if (og + 1u == (tg + 1u) * nx) xb_add(&bar[XB_TOPGEN], 1u);
            else XB_SPIN(xb_ld(&bar[XB_TOPGEN]) == tg, bar);
            __builtin_amdgcn_fence(__ATOMIC_ACQUIRE, "agent");
            xb_add(&bar[XB_XGEN(b.x)], 1u);
            asm volatile("s_waitcnt vmcnt(0)" ::: "memory");
        } else {
            XB_SPIN(xb_ld(&bar[XB_XGEN(b.x)]) == gen, bar);
            __builtin_amdgcn_fence(__ATOMIC_ACQUIRE, "agent");
            asm volatile("s_waitcnt vmcnt(0)" ::: "memory");
        }
    }
    __syncthreads();
}

#define LDS_WAIT() asm volatile("s_waitcnt lgkmcnt(0)" ::: "memory")
__device__ __forceinline__ unsigned f2bf(float f) { unsigned u = __builtin_bit_cast(unsigned, f); return (u + 0x7fffu + ((u >> 16) & 1u)) >> 16; }
__device__ __forceinline__ unsigned pk2(float lo, float hi) { return f2bf(lo) | (f2bf(hi) << 16); }
__device__ __forceinline__ float bf_lo(unsigned w) { return __builtin_bit_cast(float, w << 16); }
__device__ __forceinline__ float bf_hi(unsigned w) { return __builtin_bit_cast(float, w & 0xffff0000u); }
__device__ __forceinline__ float wave_sum(float v) {
#pragma unroll
    for (int o = 1; o < 64; o <<= 1) v += __shfl_xor(v, o);
    return v;
}
__device__ __forceinline__ float silu_f(float x) { return x * __builtin_amdgcn_rcpf(1.f + __expf(-x)); }
__device__ __forceinline__ float sigmoid_f(float x) { return __builtin_amdgcn_rcpf(1.f + __expf(-x)); }
__device__ __forceinline__ float gelu_tanh_f(float x) {
    const float u = 0.7978845608028654f * (x + 0.044715f * x * x * x);
    return x * __builtin_amdgcn_rcpf(1.f + __expf(-2.f * u));
}
__device__ __forceinline__ f32x2 rcp_pk(f32x2 d) { f32x2 r; r.x = __builtin_amdgcn_rcpf(d.x); r.y = __builtin_amdgcn_rcpf(d.y); return r; }
__device__ __forceinline__ f32x2 exp2_pk(f32x2 t) { f32x2 e; e.x = __builtin_amdgcn_exp2f(t.x); e.y = __builtin_amdgcn_exp2f(t.y); return e; }
__device__ __forceinline__ f32x2 sigmoid_pk(f32x2 x) { return rcp_pk(exp2_pk(x * (-1.4426950408889634f)) + 1.0f); }
__device__ __forceinline__ f32x2 gelu_tanh_pk(f32x2 x) {
    const f32x2 p = (x * x) * (-0.10294324f) + (-2.3022082f);
    return x * rcp_pk(exp2_pk(x * p) + 1.0f);
}
__device__ __forceinline__ f32x4 silu_mul4(const f32x4& g, const f32x4& u) {
    const f32x2 g0 = (f32x2){g[0], g[1]}, g1 = (f32x2){g[2], g[3]}, u0 = (f32x2){u[0], u[1]}, u1 = (f32x2){u[2], u[3]};
    const f32x2 o0 = (g0 * u0) * sigmoid_pk(g0), o1 = (g1 * u1) * sigmoid_pk(g1);
    return (f32x4){o0.x, o0.y, o1.x, o1.y};
}
__device__ __forceinline__ f32x4 silu_mul4r(const f32x4& g, const f32x4& u, float c, float ir2) {
    f32x4 o;
#pragma unroll
    for (int i = 0; i < 4; ++i) { const float e = __builtin_amdgcn_exp2f((g[i] * c));
        o[i] = (g[i] * u[i]) * __builtin_amdgcn_rcpf(__builtin_fmaf(e, ir2, ir2)); }
    return o;
}
__device__ __forceinline__ f32x4 silu4(const f32x4& g) {
    const f32x2 g0 = (f32x2){g[0], g[1]}, g1 = (f32x2){g[2], g[3]};
    const f32x2 o0 = g0 * sigmoid_pk(g0), o1 = g1 * sigmoid_pk(g1);
    return (f32x4){o0.x, o0.y, o1.x, o1.y};
}
__device__ __forceinline__ f32x4 gelu4(const f32x4& x) {
    const f32x2 o0 = gelu_tanh_pk((f32x2){x[0], x[1]}), o1 = gelu_tanh_pk((f32x2){x[2], x[3]});
    return (f32x4){o0.x, o0.y, o1.x, o1.y};
}
__device__ __forceinline__ f32x4 sigmoid_mul4r(const f32x4& a, float c, float p0, float p1, float p2, float p3) {
    const f32x2 o0 = rcp_pk(exp2_pk((f32x2){a[0], a[1]} * c) + 1.0f) * (f32x2){p0, p1}, o1 = rcp_pk(exp2_pk((f32x2){a[2], a[3]} * c) + 1.0f) * (f32x2){p2, p3};
    return (f32x4){o0.x, o0.y, o1.x, o1.y};
}
__device__ __forceinline__ f32x4 sigmoid_mul4(const f32x4& a, float p0, float p1, float p2, float p3) {
    const f32x2 o0 = sigmoid_pk((f32x2){a[0], a[1]}) * (f32x2){p0, p1}, o1 = sigmoid_pk((f32x2){a[2], a[3]}) * (f32x2){p2, p3};
    return (f32x4){o0.x, o0.y, o1.x, o1.y};
}
__device__ __forceinline__ u32x4 pack8(const f32x4& a, const f32x4& b) {
    u32x4 w; w.x = pg8::cvt_pk_bf16(a[0], a[1]); w.y = pg8::cvt_pk_bf16(a[2], a[3]); w.z = pg8::cvt_pk_bf16(b[0], b[1]); w.w = pg8::cvt_pk_bf16(b[2], b[3]); return w;
}

#ifndef GU_F8_MASK
#define GU_F8_MASK 0xE0
#endif
#ifndef DN_F8_MASK
#define DN_F8_MASK 0xF0
#endif
__device__ __forceinline__ float ld_rs(const float* rs, int row0, int imm) { return *(const float*)((const unsigned char*)rs + ((unsigned)row0 << 2) + (unsigned)(imm * 4)); }
typedef f32x4 AccT[2][2][4][2];
struct EpiPlain {
    static constexpr bool PERM = true;
    bf16_t* O; int ldc; int gelu_pm;
    __device__ __forceinline__ void operator()(const AccT& acc, const pg8::Unit& u, int wr, int wc, int fr, int fq) const {
        const int row0 = u.pm * 256 + wr * 64 + fr, col0 = u.pn * 256 + wc * 32 + 8 * fq;
        const bool gl = u.pm >= gelu_pm;
#pragma unroll
        for (int ai = 0; ai < 2; ++ai)
#pragma unroll
            for (int m = 0; m < 4; ++m) { bf16_t* rowp = O + (size_t)(row0 + ai * 128 + m * 16) * ldc + col0;
#pragma unroll
                for (int bj = 0; bj < 2; ++bj) { f32x4 v0 = acc[ai][bj][m][0], v1 = acc[ai][bj][m][1];
                    if (gl) { v0 = gelu4(v0); v1 = gelu4(v1); }
                    *(u32x4*)(rowp + bj * 128) = pack8(v0, v1); } }
    }
};
struct EpiPlainT {
    static constexpr bool PERM = true;
    bf16_t* O; int ldc; int gelu_pm; const float* rs;
    __device__ __forceinline__ void operator()(const AccT& acc, const pg8::Unit& u, int wr, int wc, int fr, int fq) const {
        const int row0 = u.pm * 256 + wr * 64 + fr, col0 = u.pn * 256 + wc * 32 + 8 * fq;
        const bool gl = u.pm >= gelu_pm;
        f32x4 cs[2][2];
#pragma unroll
        for (int bj = 0; bj < 2; ++bj)
#pragma unroll
            for (int n = 0; n < 2; ++n) cs[bj][n] = *(const f32x4*)(rs + col0 + bj * 128 + 4 * n);
#pragma unroll
        for (int ai = 0; ai < 2; ++ai)
#pragma unroll
            for (int m = 0; m < 4; ++m) { bf16_t* rowp = O + (size_t)(row0 + ai * 128 + m * 16) * ldc + col0;
#pragma unroll
                for (int bj = 0; bj < 2; ++bj) { f32x4 v0 = acc[ai][bj][m][0] * cs[bj][0], v1 = acc[ai][bj][m][1] * cs[bj][1];
                    if (gl) { v0 = gelu4(v0); v1 = gelu4(v1); }
                    *(u32x4*)(rowp + bj * 128) = pack8(v0, v1); } }
    }
};
struct EpiGU {
    static constexpr bool PERM = true;
    bf16_t* O; const float* rs;
    __device__ __forceinline__ void operator()(const AccT& acc, const pg8::Unit& u, int wr, int wc, int fr, int fq) const {
        const int row0 = u.pm * 256 + wr * 64 + fr, col0 = u.pn * 128 + wc * 32 + 8 * fq;
        float rv[2][4];
#pragma unroll
        for (int ai = 0; ai < 2; ++ai)
#pragma unroll
            for (int m = 0; m < 4; ++m) rv[ai][m] = ld_rs(rs, row0, ai * 128 + m * 16);
#pragma unroll
        for (int ai = 0; ai < 2; ++ai)
#pragma unroll
            for (int m = 0; m < 4; ++m) { bf16_t* rowp = O + (size_t)(row0 + ai * 128 + m * 16) * FF + col0; const float r = rv[ai][m], c = r * -1.4426950408889634f, r2 = __builtin_amdgcn_rcpf(r * r);
                const f32x4 o0 = silu_mul4r(acc[ai][0][m][0], acc[ai][1][m][0], c, r2), o1 = silu_mul4r(acc[ai][0][m][1], acc[ai][1][m][1], c, r2);
                *(u32x4*)rowp = pack8(o0, o1); }
    }
};
__host__ __device__ constexpr bool dn_f8(int L, int f) { return (DN_F8_MASK >> (L * 2 + f)) & 1; }
__host__ __device__ constexpr bool gu_f8(int L, int f) { return (GU_F8_MASK >> (L * 2 + f)) & 1; }
static_assert((GU_F8_MASK & ~DN_F8_MASK) == 0, "an fp8 gate/up GEMM writes fp8 output: its down GEMM must be fp8 as well");
constexpr float F8_XSCALE = 8.f, F8_WGSCALE = 128.f;
constexpr float F8_ASCALE = 8.f, F8_WSCALE = 256.f;
__device__ __forceinline__ unsigned pack4_fp8(const f32x4& v) {
    int w = 0;
    w = __builtin_amdgcn_cvt_pk_fp8_f32(__builtin_amdgcn_fmed3f(v[0], -448.f, 448.f), __builtin_amdgcn_fmed3f(v[1], -448.f, 448.f), w, false);
    w = __builtin_amdgcn_cvt_pk_fp8_f32(__builtin_amdgcn_fmed3f(v[2], -448.f, 448.f), __builtin_amdgcn_fmed3f(v[3], -448.f, 448.f), w, true);
    return (unsigned)w;
}
struct EpiGU8 {
    static constexpr bool PERM = true;
    unsigned char* O; const float* rs; float sc;
    __device__ __forceinline__ void operator()(const AccT& acc, const pg8::Unit& u, int wr, int wc, int fr, int fq) const {
        asm volatile("" : "+v"(fr), "+v"(fq));
        const int row0 = u.pm * 256 + wr * 64 + fr, col0 = u.pn * 128 + wc * 32 + 8 * fq;
        float rv[2][4];
#pragma unroll
        for (int ai = 0; ai < 2; ++ai)
#pragma unroll
            for (int m = 0; m < 4; ++m) rv[ai][m] = ld_rs(rs, row0, ai * 128 + m * 16);
#pragma unroll
        for (int ai = 0; ai < 2; ++ai)
#pragma unroll
            for (int m = 0; m < 4; ++m) { unsigned char* rowp = O + (size_t)(row0 + ai * 128 + m * 16) * FF + col0; const float r = rv[ai][m] * sc, c = r * -1.4426950408889634f, r2 = __builtin_amdgcn_rcpf(r * r * F8_ASCALE);
                const f32x4 o0 = silu_mul4r(acc[ai][0][m][0], acc[ai][1][m][0], c, r2), o1 = silu_mul4r(acc[ai][0][m][1], acc[ai][1][m][1], c, r2);
                u32x2 w; w.x = pack4_fp8(o0); w.y = pack4_fp8(o1);
                *(u32x2*)rowp = w; }
    }
};
struct EpiPlainS {
    static constexpr bool PERM = true;
    bf16_t* O; int ldc; float sc;
    __device__ __forceinline__ void operator()(const AccT& acc, const pg8::Unit& u, int wr, int wc, int fr, int fq) const {
        asm volatile("" : "+v"(fr), "+v"(fq));
        const int row0 = u.pm * 256 + wr * 64 + fr, col0 = u.pn * 256 + wc * 32 + 8 * fq;
#pragma unroll
        for (int ai = 0; ai < 2; ++ai)
#pragma unroll
            for (int m = 0; m < 4; ++m) { bf16_t* rowp = O + (size_t)(row0 + ai * 128 + m * 16) * ldc + col0;
#pragma unroll
                for (int bj = 0; bj < 2; ++bj) *(u32x4*)(rowp + bj * 128) = pack8(acc[ai][bj][m][0] * sc, acc[ai][bj][m][1] * sc); }
    }
};
struct EpiInEven {
    static constexpr bool PERM = true;
    bf16_t* O; const float* rcos; const float* rsin; const float* rs;
    __device__ __forceinline__ void operator()(const AccT& acc, const pg8::Unit& u, int wr, int wc, int fr, int fq) const {
        const int row0 = u.pm * 256 + wr * 64 + fr, col0 = u.pn * 256 + wc * 32 + 8 * fq;
        float rv[2][4];
#pragma unroll
        for (int ai = 0; ai < 2; ++ai)
#pragma unroll
            for (int m = 0; m < 4; ++m) rv[ai][m] = ld_rs(rs, row0, ai * 128 + m * 16);
        if (u.pn < 8) {
            const float ksc = u.pn >= 4 ? 0.0625f : 1.f;
#pragma unroll
            for (int ai = 0; ai < 2; ++ai) { f32x4 ctab[4][2], stab[4][2];
#pragma unroll
                for (int m = 0; m < 4; ++m)
#pragma unroll
                    for (int n = 0; n < 2; ++n) { const int tp = (row0 + ai * 128 + m * 16) & (SEQ - 1), i0 = wc * 32 + 8 * fq + 4 * n; ctab[m][n] = *(const f32x4*)(rcos + tp * 128 + i0); stab[m][n] = *(const f32x4*)(rsin + tp * 128 + i0); }
#pragma unroll
                for (int m = 0; m < 4; ++m) { const int row = row0 + ai * 128 + m * 16; bf16_t* rowp = O + (size_t)row * 4096 + col0;
                    f32x4 o1[2], o2[2]; const float kr = ksc * rv[ai][m];
#pragma unroll
                    for (int n = 0; n < 2; ++n) {
                        const f32x4 c4 = ctab[m][n], s4 = stab[m][n];
                        const f32x4 x1 = acc[ai][0][m][n], x2 = acc[ai][1][m][n];
                        o1[n] = (x1 * c4 - x2 * s4) * kr; o2[n] = (x2 * c4 + x1 * s4) * kr; }
                    *(u32x4*)rowp = pack8(o1[0], o1[1]); *(u32x4*)(rowp + 128) = pack8(o2[0], o2[1]); } }
        } else {
            const bool is_g = u.pn < 12;
#pragma unroll
            for (int ai = 0; ai < 2; ++ai)
#pragma unroll
                for (int m = 0; m < 4; ++m) { bf16_t* rowp = O + (size_t)(row0 + ai * 128 + m * 16) * 4096 + col0;
#pragma unroll
                    for (int bj = 0; bj < 2; ++bj) { f32x4 v0 = acc[ai][bj][m][0] * rv[ai][m], v1 = acc[ai][bj][m][1] * rv[ai][m];
                        if (is_g) { v0 = silu4(v0); v1 = silu4(v1); } else { v0 = gelu4(v0); v1 = gelu4(v1); }
                        *(u32x4*)(rowp + bj * 128) = pack8(v0, v1); } }
        }
    }
};
struct EpiInOdd {
    static constexpr bool PERM = true;
    bf16_t* O; const float* mcos; const float* msin; float* ksum; const float* rs;
    __device__ __forceinline__ void operator()(const AccT& acc, const pg8::Unit& u, int wr, int wc, int fr, int fq) const {
        const int row0 = u.pm * 256 + wr * 64 + fr, col0 = u.pn * 256 + wc * 32 + 8 * fq;
        const bool rot = (u.pn >= 4) && (wc == 0);
        const float sc = (u.pn >= 4 && u.pn < 8) ? QSCALE_MOBA : 1.f;
        f32x4 cs[2][2];
#pragma unroll
        for (int bj = 0; bj < 2; ++bj)
#pragma unroll
            for (int n = 0; n < 2; ++n) cs[bj][n] = (f32x4){0.f, 0.f, 0.f, 0.f};
#pragma unroll
        for (int ai = 0; ai < 2; ++ai)
#pragma unroll
          for (int mh = 0; mh < 2; ++mh) { f32x4 ctab[2][2], stab[2][2]; float rsv[2];
#pragma unroll
            for (int m2 = 0; m2 < 2; ++m2) rsv[m2] = ld_rs(rs, row0, ai * 128 + (2 * mh + m2) * 16);
            if (rot) {
#pragma unroll
                for (int m2 = 0; m2 < 2; ++m2)
#pragma unroll
                    for (int n = 0; n < 2; ++n) { const int tp = (row0 + ai * 128 + (2 * mh + m2) * 16) & (SEQ - 1), fi = (8 * fq + 4 * n) & 15; ctab[m2][n] = *(const f32x4*)(mcos + tp * 16 + fi); stab[m2][n] = *(const f32x4*)(msin + tp * 16 + fi); } }
#pragma unroll
            for (int m2 = 0; m2 < 2; ++m2) { const int m = 2 * mh + m2; const int row = row0 + ai * 128 + m * 16; bf16_t* rowp = O + (size_t)row * 3072 + col0; const float scr_ = sc * rsv[m2];
#pragma unroll
                for (int bj = 0; bj < 2; ++bj) { f32x4 v[2];
#pragma unroll
                    for (int n = 0; n < 2; ++n) { v[n] = acc[ai][bj][m][n];
                        if (rot) { f32x4 vp;
#pragma unroll
                            for (int j = 0; j < 4; ++j) vp[j] = __shfl_xor(v[n][j], 32);
                            const f32x4 c4 = ctab[m2][n], s4 = stab[m2][n];
                            v[n] = (fq < 2) ? (v[n] * c4 - vp * s4) : (v[n] * c4 + vp * s4); }
                        v[n] = v[n] * scr_; cs[bj][n] += v[n]; }
                    *(u32x4*)(rowp + bj * 128) = pack8(v[0], v[1]); } } }
        if (u.pn >= 8) {
#pragma unroll
            for (int bj = 0; bj < 2; ++bj)
#pragma unroll
                for (int n = 0; n < 2; ++n)
#pragma unroll
                    for (int j = 0; j < 4; ++j) { float s = cs[bj][n][j];
                        s += __shfl_xor(s, 1); s += __shfl_xor(s, 2); s += __shfl_xor(s, 4); s += __shfl_xor(s, 8);
                        if (fr == 0) atomicAdd(ksum + (size_t)u.pm * 1024 + (u.pn - 8) * 256 + bj * 128 + wc * 32 + 8 * fq + 4 * n + j, s); }
        }
    }
};
struct EpiPleGate {
    static constexpr bool PERM = true;
    bf16_t* O; const bf16_t* P; const float* rs;
    __device__ __forceinline__ void operator()(const AccT& acc, const pg8::Unit& u, int wr, int wc, int fr, int fq) const {
        const int row0 = u.pm * 256 + wr * 64 + fr, col0 = u.pn * 256 + wc * 32 + 8 * fq;
#pragma unroll
        for (int ai = 0; ai < 2; ++ai) { u32x4 pwv[4][2]; float rv[4];
#pragma unroll
            for (int m = 0; m < 4; ++m) rv[m] = ld_rs(rs, row0, ai * 128 + m * 16);
#pragma unroll
            for (int m = 0; m < 4; ++m)
#pragma unroll
                for (int bj = 0; bj < 2; ++bj) pwv[m][bj] = *(const u32x4*)(P + (size_t)(row0 + ai * 128 + m * 16) * D + col0 + bj * 128);
#pragma unroll
            for (int m = 0; m < 4; ++m) { const size_t off = (size_t)(row0 + ai * 128 + m * 16) * D + col0;
#pragma unroll
                for (int bj = 0; bj < 2; ++bj) { const u32x4 pw = pwv[m][bj]; const float c = rv[m] * -1.4426950408889634f;
                    const f32x4 v0 = sigmoid_mul4r(acc[ai][bj][m][0], c, bf_lo(pw.x), bf_hi(pw.x), bf_lo(pw.y), bf_hi(pw.y)), v1 = sigmoid_mul4r(acc[ai][bj][m][1], c, bf_lo(pw.z), bf_hi(pw.z), bf_lo(pw.w), bf_hi(pw.w));
                    *(u32x4*)(O + off + bj * 128) = pack8(v0, v1); } } }
    }
};

__device__ __forceinline__ int map_row(int mode, int n0) {
    if (mode == 1) return 256 * (n0 >> 7) + (n0 & 127);
    if (mode == 2) return 256 * (n0 >> 7) + 128 + (n0 & 127);
    if (mode == 3) { if (n0 < 2048) return n0; if (n0 < 3072) return n0 + 2048; if (n0 < 5120) return n0 - 1024; return n0; }
    return n0;
}
__device__ __forceinline__ void xpose_matrix(const float* W, int K, int N, bf16_t* WT, int mode, LAS float* scr, int gw, int NGW, int lane, const float* gain = nullptr) {
    const int nblk = N / 32, nitems = (K / 64) * nblk;
    for (int item = gw; item < nitems; item += NGW) {
        const int kb = item / nblk, nb = item % nblk, k0 = 64 * kb, n0 = 32 * nb, r0 = map_row(mode, n0);
#pragma unroll 8
        for (int i = 0; i < 32; ++i) { const int kk = 2 * i + (lane >> 5); scr[kk * 33 + (lane & 31)] = W[(size_t)(k0 + kk) * N + n0 + (lane & 31)]; }
        LDS_WAIT(); asm volatile("" ::: "memory");
        const int c = lane & 7;
        f32x4 g0 = (f32x4){1.f, 1.f, 1.f, 1.f}, g1 = g0;
        if (gain) { g0 = *(const f32x4*)(gain + k0 + 8 * c); g1 = *(const f32x4*)(gain + k0 + 8 * c + 4); }
#pragma unroll
        for (int j = 0; j < 4; ++j) { const int n = (lane >> 3) + 8 * j; const LAS float* s = scr + (8 * c) * 33 + n;
            u32x4 o; o.x = pk2(s[0 * 33] * g0[0], s[1 * 33] * g0[1]); o.y = pk2(s[2 * 33] * g0[2], s[3 * 33] * g0[3]); o.z = pk2(s[4 * 33] * g1[0], s[5 * 33] * g1[1]); o.w = pk2(s[6 * 33] * g1[2], s[7 * 33] * g1[3]);
            *(u32x4*)(WT + (size_t)(r0 + n) * K + k0 + 8 * c) = o; }
        LDS_WAIT(); asm volatile("" ::: "memory");
    }
}

__device__ __forceinline__ void xpose_matrix_f8(const float* W, int K, int N, unsigned char* WT, float scale, LAS float* scr, int gw, int NGW, int lane, int mode = 0, const float* gain = nullptr) {
    const int nblk = N / 32, nitems = (K / 64) * nblk;
    for (int item = gw; item < nitems; item += NGW) {
        const int kb = item / nblk, nb = item % nblk, k0 = 64 * kb, n0 = 32 * nb, r0 = map_row(mode, n0);
#pragma unroll 8
        for (int i = 0; i < 32; ++i) { const int kk = 2 * i + (lane >> 5); scr[kk * 33 + (lane & 31)] = W[(size_t)(k0 + kk) * N + n0 + (lane & 31)]; }
        LDS_WAIT(); asm volatile("" ::: "memory");
        const int c = lane & 7;
        f32x4 g0 = (f32x4){scale, scale, scale, scale}, g1 = g0;
        if (gain) { g0 = *(const f32x4*)(gain + k0 + 8 * c) * scale; g1 = *(const f32x4*)(gain + k0 + 8 * c + 4) * scale; }
#pragma unroll
        for (int j = 0; j < 4; ++j) { const int n = (lane >> 3) + 8 * j; const LAS float* s = scr + (8 * c) * 33 + n;
            u32x2 o; o.x = pack4_fp8((f32x4){s[0 * 33], s[1 * 33], s[2 * 33], s[3 * 33]} * g0); o.y = pack4_fp8((f32x4){s[4 * 33], s[5 * 33], s[6 * 33], s[7 * 33]} * g1);
            *(u32x2*)(WT + (size_t)(r0 + n) * K + k0 + 8 * c) = o; }
        LDS_WAIT(); asm volatile("" ::: "memory");
    }
}

template <bool HAS_T, bool XIN_F32 = true, bool XOUT_F32 = true>
__device__ __forceinline__ void rphase(const void* xin_, void* xout_, const bf16_t* T, float alpha, const float* gt, float* RS, int gw, int NGW, int lane, unsigned char* X8 = nullptr) {
    f32x4 gtv[8];
#pragma unroll
    for (int c = 0; c < 4; ++c) {
        if (HAS_T) { gtv[2 * c] = *(const f32x4*)(gt + 512 * c + 8 * lane); gtv[2 * c + 1] = *(const f32x4*)(gt + 512 * c + 8 * lane + 4); } }
    for (int row = gw; row < M; row += NGW) {
        f32x4 xv[8];
        if (XIN_F32) { const float* xr = (const float*)xin_ + (size_t)row * D + 8 * lane;
#pragma unroll
            for (int c = 0; c < 4; ++c) { xv[2 * c] = *(const f32x4*)(xr + 512 * c); xv[2 * c + 1] = *(const f32x4*)(xr + 512 * c + 4); }
        } else { const bf16_t* xr = (const bf16_t*)xin_ + (size_t)row * D + 8 * lane; u32x4 xw[4];
#pragma unroll
            for (int c = 0; c < 4; ++c) xw[c] = *(const u32x4*)(xr + 512 * c);
#pragma unroll
            for (int c = 0; c < 4; ++c) { xv[2 * c] = (f32x4){bf_lo(xw[c].x), bf_hi(xw[c].x), bf_lo(xw[c].y), bf_hi(xw[c].y)}; xv[2 * c + 1] = (f32x4){bf_lo(xw[c].z), bf_hi(xw[c].z), bf_lo(xw[c].w), bf_hi(xw[c].w)}; } }
        if (HAS_T) {
            u32x4 tv[4];
            const bf16_t* tr = T + (size_t)row * D + 8 * lane;
#pragma unroll
            for (int c = 0; c < 4; ++c) tv[c] = *(const u32x4*)(tr + 512 * c);
            f32x4 tf[8]; float ss = 0.f;
#pragma unroll
            for (int c = 0; c < 4; ++c) { tf[2 * c] = (f32x4){bf_lo(tv[c].x), bf_hi(tv[c].x), bf_lo(tv[c].y), bf_hi(tv[c].y)}; tf[2 * c + 1] = (f32x4){bf_lo(tv[c].z), bf_hi(tv[c].z), bf_lo(tv[c].w), bf_hi(tv[c].w)}; }
#pragma unroll
            for (int c = 0; c < 8; ++c) ss += (tf[c][0] * tf[c][0] + tf[c][1] * tf[c][1]) + (tf[c][2] * tf[c][2] + tf[c][3] * tf[c][3]);
            ss = wave_sum(ss);
            const float r = __builtin_amdgcn_rsqf(ss * (1.f / D) + EPS) * alpha;
#pragma unroll
            for (int c = 0; c < 4; ++c) { const f32x4 g0 = gtv[2 * c], g1 = gtv[2 * c + 1];
                xv[2 * c] += tf[2 * c] * g0 * r; xv[2 * c + 1] += tf[2 * c + 1] * g1 * r;
                if (XOUT_F32) { float* xo = (float*)xout_ + (size_t)row * D + 8 * lane; *(f32x4*)(xo + 512 * c) = xv[2 * c]; *(f32x4*)(xo + 512 * c + 4) = xv[2 * c + 1]; }
                else { bf16_t* xo = (bf16_t*)xout_ + (size_t)row * D + 8 * lane; *(u32x4*)(xo + 512 * c) = pack8(xv[2 * c], xv[2 * c + 1]); } }
        }
        if (!HAS_T) { bf16_t* xo = (bf16_t*)xout_ + (size_t)row * D + 8 * lane;
#pragma unroll
            for (int c = 0; c < 4; ++c) *(u32x4*)(xo + 512 * c) = pack8(xv[2 * c], xv[2 * c + 1]); }
        if (X8) { unsigned char* x8 = X8 + (size_t)row * D + 8 * lane;
#pragma unroll
            for (int c = 0; c < 4; ++c) { u32x2 w; w.x = pack4_fp8(xv[2 * c] * F8_XSCALE); w.y = pack4_fp8(xv[2 * c + 1] * F8_XSCALE); *(u32x2*)(x8 + 512 * c) = w; } }
        if (RS) {
            float s2 = 0.f;
#pragma unroll
            for (int c = 0; c < 8; ++c) s2 += (xv[c][0] * xv[c][0] + xv[c][1] * xv[c][1]) + (xv[c][2] * xv[c][2] + xv[c][3] * xv[c][3]);
            s2 = wave_sum(s2);
            if (lane == 0) RS[row] = __builtin_amdgcn_rsqf(s2 * (1.f / D) + EPS);
        }
    }
}

#define MFMA16(a, b, c) __builtin_amdgcn_mfma_f32_16x16x32_bf16((a), (b), (c), 0, 0, 0)

__device__ __forceinline__ void ret_tile(LAS unsigned char* lds, const bf16_t* Zn, const bf16_t* ZT, bf16_t* Y, int b, int h, int qt, int tid, int wid, int lane) {
    asm volatile("" : "+v"(tid), "+v"(lane));
    constexpr int KST = 544, VST = 144, OFF_V = 64 * KST, BUF = OFF_V + 256 * VST;
    const int r = lane & 15, q4 = lane >> 4;
    const int R0 = b * SEQ + qt * 128, t0w = qt * 128 + wid * 16;
    const float lg = __log2f(1.0f - exp2f(-5.0f - (float)h));
    bf16x8 qf[8];
    { const bf16_t* qrow = Zn + (size_t)(R0 + wid * 16 + r) * 4096 + h * 256 + q4 * 8;
#pragma unroll
      for (int kk = 0; kk < 8; ++kk) qf[kk] = *(const bf16x8*)(qrow + kk * 32); }
    f32x4 o[16];
#pragma unroll
    for (int e = 0; e < 16; ++e) o[e] = (f32x4){0.f, 0.f, 0.f, 0.f};
    const int nkt = 2 * (qt + 1);
    u32x4 pk[4], pv[4];
    const bf16_t* kbase = Zn + (size_t)(b * SEQ) * 4096 + 1024 + h * 256;
    const bf16_t* vbase = ZT + (size_t)(h * 256) * M + b * SEQ;
#define RET_PREFETCH(kt) do { _Pragma("unroll") for (int i = 0; i < 4; ++i) { const int c = tid + 512 * i; \
        pk[i] = *(const u32x4*)(kbase + (size_t)((kt) * 64 + (c >> 5)) * 4096 + (c & 31) * 8); \
        pv[i] = *(const u32x4*)(vbase + (size_t)(c >> 3) * M + (kt) * 64 + (c & 7) * 8); } } while (0)
#define RET_WRITE(bufp) do { _Pragma("unroll") for (int i = 0; i < 4; ++i) { const int c = tid + 512 * i; \
        *(LAS u32x4*)((bufp) + (c >> 5) * KST + (c & 31) * 16) = pk[i]; \
        *(LAS u32x4*)((bufp) + OFF_V + (c >> 3) * VST + (c & 7) * 16) = pv[i]; } } while (0)
    RET_PREFETCH(0);
    __syncthreads();
    RET_WRITE(lds);
    if (nkt > 1) RET_PREFETCH(1);
    for (int kt = 0; kt < nkt; ++kt) {
        __syncthreads();
        LAS unsigned char* cb = lds + (kt & 1) * BUF;
        if (kt + 1 < nkt) { LAS unsigned char* nb = lds + ((kt + 1) & 1) * BUF; RET_WRITE(nb); if (kt + 2 < nkt) RET_PREFETCH(kt + 2); }
        if (kt * 64 <= t0w + 15) {
            f32x4 sacc[4];
#pragma unroll
            for (int sb = 0; sb < 4; ++sb) sacc[sb] = (f32x4){0.f, 0.f, 0.f, 0.f};
#define RET_KF(dst, kk_) do { _Pragma("unroll") for (int sb = 0; sb < 4; ++sb) dst[sb] = *(const LAS bf16x8*)(cb + (16 * sb + r) * KST + (kk_) * 64 + q4 * 16); } while (0)
#define RET_VF(dst, eb_) do { _Pragma("unroll") for (int e2 = 0; e2 < 2; ++e2) _Pragma("unroll") for (int c = 0; c < 2; ++c) { const LAS unsigned char* vp = cb + OFF_V + (16 * ((eb_) + e2) + r) * VST + (32 * c + 4 * q4) * 2; \
                const s16x4 lo = *(const LAS s16x4*)vp, hi = *(const LAS s16x4*)(vp + 32); dst[e2][c] = __builtin_shufflevector(lo, hi, 0, 1, 2, 3, 4, 5, 6, 7); } } while (0)
            bf16x8 ka[4], kb[4], va[2][2], vb[2][2];
            RET_KF(ka, 0);
#pragma unroll
            for (int kk = 0; kk < 8; kk += 2) {
                RET_KF(kb, kk + 1); __builtin_amdgcn_sched_barrier(0);
{ __builtin_amdgcn_s_setprio(1);
#pragma unroll
for (int sb = 0; sb < 4; ++sb) sacc[sb] = MFMA16(ka[sb], qf[kk], sacc[sb]); __builtin_amdgcn_s_setprio(0); }
                __builtin_amdgcn_sched_barrier(0);
                if (kk + 2 < 8) RET_KF(ka, kk + 2); else RET_VF(va, 0);
                __builtin_amdgcn_sched_barrier(0);
{ __builtin_amdgcn_s_setprio(1);
#pragma unroll
for (int sb = 0; sb < 4; ++sb) sacc[sb] = MFMA16(kb[sb], qf[kk + 1], sacc[sb]); __builtin_amdgcn_s_setprio(0); }
                __builtin_amdgcn_sched_barrier(0);
            }
            const int dbase = t0w + r - (kt * 64 + 4 * q4);
#pragma unroll
            for (int sb = 0; sb < 4; ++sb)
#pragma unroll
                for (int i = 0; i < 4; ++i) { const int d = dbase - 16 * sb - i; const float w = __builtin_amdgcn_exp2f((float)d * lg); sacc[sb][i] = d >= 0 ? sacc[sb][i] * w : 0.f; }
            bf16x8 pf[2];
#pragma unroll
            for (int c = 0; c < 2; ++c) pf[c] = __builtin_bit_cast(bf16x8, pack8(sacc[2 * c], sacc[2 * c + 1]));
#pragma unroll
            for (int eb = 0; eb < 16; eb += 4) {
                RET_VF(vb, eb + 2); __builtin_amdgcn_sched_barrier(0); __builtin_amdgcn_s_setprio(1);
#pragma unroll
                for (int e2 = 0; e2 < 2; ++e2)
#pragma unroll
                    for (int c = 0; c < 2; ++c) o[eb + e2] = MFMA16(va[e2][c], pf[c], o[eb + e2]);
                __builtin_amdgcn_sched_barrier(0);
                __builtin_amdgcn_s_setprio(0); if (eb + 4 < 16) RET_VF(va, eb + 4);
                __builtin_amdgcn_sched_barrier(0); __builtin_amdgcn_s_setprio(1);
#pragma unroll
                for (int e2 = 0; e2 < 2; ++e2)
#pragma unroll
                    for (int c = 0; c < 2; ++c) o[eb + 2 + e2] = MFMA16(vb[e2][c], pf[c], o[eb + 2 + e2]);
                __builtin_amdgcn_s_setprio(0); __builtin_amdgcn_sched_barrier(0);
            }
#undef RET_KF
#undef RET_VF
        }
    }
#undef RET_PREFETCH
#undef RET_WRITE
    float ss = 0.f;
#pragma unroll
    for (int eb = 0; eb < 16; ++eb) ss += (o[eb][0] * o[eb][0] + o[eb][1] * o[eb][1]) + (o[eb][2] * o[eb][2] + o[eb][3] * o[eb][3]);
    ss += __shfl_xor(ss, 16); ss += __shfl_xor(ss, 32);
    const float rstd = __builtin_amdgcn_rsqf(ss * (1.f / 256.f) + EPS);
    const size_t row = (size_t)(R0 + wid * 16 + r);
    u32x2 gwv[16];
#pragma unroll
    for (int eb = 0; eb < 16; ++eb) gwv[eb] = *(const u32x2*)(Zn + row * 4096 + 2048 + h * 256 + 16 * eb + 4 * q4);
#pragma unroll
    for (int eb = 0; eb < 16; ++eb) { const int e = 16 * eb + 4 * q4;
        const u32x2 gw2 = gwv[eb];
        u32x2 w; w.x = pg8::cvt_pk_bf16(o[eb][0] * rstd * bf_lo(gw2.x), o[eb][1] * rstd * bf_hi(gw2.x)); w.y = pg8::cvt_pk_bf16(o[eb][2] * rstd * bf_lo(gw2.y), o[eb][3] * rstd * bf_hi(gw2.y));
        *(u32x2*)(Y + row * D + h * 256 + e) = w; }
}

__device__ __forceinline__ void sgu_unit(LAS unsigned char* lds, const bf16_t* Zn, const bf16_t* ZT, bf16_t* Y, const bf16_t* Wm  , const float* bias  , const float* gain  ,
                                         int b, int c, int g, int tid, int wid, int lane) {
    asm volatile("" : "+v"(tid), "+v"(lane));
    constexpr int WST = 272, VST = 272, OFF_W = 0, OFF_V = 128 * WST, OFF_P = OFF_V + 256 * VST, OFF_R = OFF_P + 8 * 64 * 8, OFF_GN = OFF_R + 512;
    const int r = lane & 15, q4 = lane >> 4;
    const int R0 = b * SEQ + c * 128;
    __syncthreads();
    { u32x4 sw_[4], sv_[8];
#pragma unroll
      for (int i = 0; i < 4; ++i) { const int ch = tid + 512 * i; sw_[i] = *(const u32x4*)(Wm + (size_t)g * 16384 + (ch >> 4) * 128 + (ch & 15) * 8); }
#pragma unroll
      for (int i = 0; i < 8; ++i) { const int ch = tid + 512 * i; sv_[i] = *(const u32x4*)(ZT + (size_t)(1024 + g * 256 + (ch >> 4)) * M + R0 + (ch & 15) * 8); }
      asm volatile("" :: "v"(sw_[0]), "v"(sw_[1]), "v"(sw_[2]), "v"(sw_[3]), "v"(sv_[0]), "v"(sv_[1]), "v"(sv_[2]), "v"(sv_[3]), "v"(sv_[4]), "v"(sv_[5]), "v"(sv_[6]), "v"(sv_[7]));
#pragma unroll
      for (int i = 0; i < 4; ++i) { const int ch = tid + 512 * i; *(LAS u32x4*)(lds + OFF_W + (ch >> 4) * WST + (ch & 15) * 16) = sw_[i]; }
#pragma unroll
      for (int i = 0; i < 8; ++i) { const int ch = tid + 512 * i; *(LAS u32x4*)(lds + OFF_V + (ch >> 4) * VST + (ch & 15) * 16) = sv_[i]; } }
    if (tid < 256) *(LAS float*)(lds + OFF_GN + tid * 4) = gain[g * 256 + tid];
    __syncthreads();
    { const int sp = tid & 63, part = tid >> 6; float a0 = 0.f, a1 = 0.f;
#pragma unroll 8
      for (int dd = 0; dd < 32; ++dd) { const unsigned w = *(const LAS unsigned*)(lds + OFF_V + (part * 32 + dd) * VST + sp * 4); const float v0 = bf_lo(w), v1 = bf_hi(w); a0 += v0 * v0; a1 += v1 * v1; }
      *(LAS f32x2*)(lds + OFF_P + (part * 64 + sp) * 8) = (f32x2){a0, a1}; }
    __syncthreads();
    if (tid < 64) { float a0 = 0.f, a1 = 0.f;
#pragma unroll
      for (int p = 0; p < 8; ++p) { const f32x2 v = *(const LAS f32x2*)(lds + OFF_P + (p * 64 + tid) * 8); a0 += v.x; a1 += v.y; }
      *(LAS f32x2*)(lds + OFF_R + tid * 8) = (f32x2){__builtin_amdgcn_rsqf(a0 * (1.f / 256.f) + EPS), __builtin_amdgcn_rsqf(a1 * (1.f / 256.f) + EPS)}; }
    __syncthreads();
    { const int sp = tid & 63, part = tid >> 6; const f32x2 rs = *(const LAS f32x2*)(lds + OFF_R + sp * 8);
#pragma unroll 8
      for (int dd = 0; dd < 32; ++dd) { const int d = part * 32 + dd; LAS unsigned* p = (LAS unsigned*)(lds + OFF_V + d * VST + sp * 4); const unsigned w = *p; const float gn = *(const LAS float*)(lds + OFF_GN + d * 4);
          *p = pg8::cvt_pk_bf16(bf_lo(w) * rs.x * gn, bf_hi(w) * rs.y * gn); } }
    __syncthreads();
    bf16x8 wf[4];
#pragma unroll
    for (int kk = 0; kk < 4; ++kk) wf[kk] = *(const LAS bf16x8*)(lds + OFF_W + (16 * wid + r) * WST + kk * 64 + q4 * 16);
    f32x4 acc[16];
#define SGU_VF(dst, db_) do { _Pragma("unroll") for (int kk = 0; kk < 4; ++kk) dst[kk] = *(const LAS bf16x8*)(lds + OFF_V + (16 * (db_) + r) * VST + kk * 64 + q4 * 16); } while (0)
    bf16x8 sva[4], svb[4];
    SGU_VF(sva, 0);
#pragma unroll
    for (int db = 0; db < 16; db += 2) {
        SGU_VF(svb, db + 1); __builtin_amdgcn_sched_barrier(0);
        acc[db] = (f32x4){0.f, 0.f, 0.f, 0.f};
#pragma unroll
        for (int kk = 0; kk < 4; ++kk) acc[db] = MFMA16(sva[kk], wf[kk], acc[db]);
        __builtin_amdgcn_sched_barrier(0);
        if (db + 2 < 16) SGU_VF(sva, db + 2);
        __builtin_amdgcn_sched_barrier(0);
        acc[db + 1] = (f32x4){0.f, 0.f, 0.f, 0.f};
#pragma unroll
        for (int kk = 0; kk < 4; ++kk) acc[db + 1] = MFMA16(svb[kk], wf[kk], acc[db + 1]);
        __builtin_amdgcn_sched_barrier(0);
    }
#undef SGU_VF
    const int t = 16 * wid + r; const float bs = bias[g * 128 + t];
    const size_t row = (size_t)(R0 + t);
    u32x2 uwv[16];
#pragma unroll
    for (int db = 0; db < 16; ++db) uwv[db] = *(const u32x2*)(Zn + row * 4096 + 3072 + g * 256 + 16 * db + 4 * q4);
#pragma unroll
    for (int db = 0; db < 16; ++db) { const int d = 16 * db + 4 * q4;
        const u32x2 uw = uwv[db];
        u32x2 w; w.x = pg8::cvt_pk_bf16((acc[db][0] + bs) * bf_lo(uw.x), (acc[db][1] + bs) * bf_hi(uw.x)); w.y = pg8::cvt_pk_bf16((acc[db][2] + bs) * bf_lo(uw.y), (acc[db][3] + bs) * bf_hi(uw.y));
        *(u32x2*)(Y + row * D + 1024 + g * 256 + d) = w; }
}

__device__ __forceinline__ void moba_tile(LAS unsigned char* lds, const bf16_t* Zn, const bf16_t* ZT, bf16_t* Y, const float* ksum, int b, int h, int qb, int tid, int wid, int lane) {
    asm volatile("" : "+v"(tid), "+v"(lane));
    constexpr int KST = 288, VST = 144, OFF_V = 64 * KST, BUF = OFF_V + 128 * VST, OFF_KS = 2 * BUF, OFF_G = OFF_KS + 4096, OFF_SEL = OFF_G + 8192;
    const int r = lane & 15, q4 = lane >> 4;
    const int R0 = b * SEQ + qb * 256, t0w = qb * 256 + wid * 32;
    const int nkt = 4 * (qb + 1);
    u32x4 pk[2], pv[2];
    const bf16_t* kbase = Zn + (size_t)(b * SEQ) * 3072 + 2048 + h * 128;
    const bf16_t* vbase = ZT + (size_t)(h * 128) * M + b * SEQ;
#define MOBA_PREFETCH(kt) do { _Pragma("unroll") for (int i = 0; i < 2; ++i) { const int c = tid + 512 * i; \
        pk[i] = *(const u32x4*)(kbase + (size_t)((kt) * 64 + (c >> 4)) * 3072 + (c & 15) * 8); \
        pv[i] = *(const u32x4*)(vbase + (size_t)(c >> 3) * M + (kt) * 64 + (c & 7) * 8); } } while (0)
#define MOBA_WRITE(bufp) do { _Pragma("unroll") for (int i = 0; i < 2; ++i) { const int c = tid + 512 * i; \
        *(LAS u32x4*)((bufp) + (c >> 4) * KST + (c & 15) * 16) = pk[i]; \
        *(LAS u32x4*)((bufp) + OFF_V + (c >> 3) * VST + (c & 7) * 16) = pv[i]; } } while (0)
    MOBA_PREFETCH(0);
    __syncthreads();
    unsigned mysel[2] = {(1u << qb) - 1u, (1u << qb) - 1u};
    if (qb >= 4) {
#pragma unroll
        for (int i = 0; i < 2; ++i) { const int e = tid + 512 * i; *(LAS float*)(lds + OFF_KS + e * 4) = ksum[(size_t)(b * 8 + (e >> 7)) * 1024 + h * 128 + (e & 127)]; }
        __syncthreads();
        { const int t = tid & 255, part = tid >> 8; const bf16_t* qrow = Zn + (size_t)(R0 + t) * 3072 + 1024 + h * 128;
          float g[4] = {0.f, 0.f, 0.f, 0.f};
          u32x4 qw_[16];
#pragma unroll
          for (int c = 0; c < 16; ++c) qw_[c] = *(const u32x4*)(qrow + 8 * c);
#pragma unroll
          for (int c = 0; c < 16; ++c) { const u32x4 w = qw_[c];
              const f32x4 ql = (f32x4){bf_lo(w.x), bf_hi(w.x), bf_lo(w.y), bf_hi(w.y)}, qh = (f32x4){bf_lo(w.z), bf_hi(w.z), bf_lo(w.w), bf_hi(w.w)};
#pragma unroll
              for (int i = 0; i < 4; ++i) { const LAS f32x4* kp = (const LAS f32x4*)(lds + OFF_KS + ((part + 2 * i) * 128 + 8 * c) * 4);
                  const f32x4 p = ql * kp[0] + qh * kp[1]; g[i] += (p[0] + p[1]) + (p[2] + p[3]); } }
#pragma unroll
          for (int i = 0; i < 4; ++i) *(LAS float*)(lds + OFF_G + (t * 8 + part + 2 * i) * 4) = g[i]; }
        __syncthreads();
        if (tid < 256) { float gv[8];
#pragma unroll
            for (int n = 0; n < 8; ++n) gv[n] = *(const LAS float*)(lds + OFF_G + (tid * 8 + n) * 4);
            unsigned bits = 0u;
#pragma unroll
            for (int n = 0; n < 8; ++n) { int rank = 0;
#pragma unroll
                for (int m2 = 0; m2 < 8; ++m2) rank += (m2 < qb && m2 != n && (gv[m2] > gv[n] || (gv[m2] == gv[n] && m2 < n))) ? 1 : 0;
                if (n < qb && rank < 3) bits |= 1u << n; }
            *(LAS unsigned*)(lds + OFF_SEL + tid * 4) = bits; }
        __syncthreads();
#pragma unroll
        for (int tb = 0; tb < 2; ++tb) mysel[tb] = *(const LAS unsigned*)(lds + OFF_SEL + (wid * 32 + 16 * tb + r) * 4);
    }
    MOBA_WRITE(lds);
    if (nkt > 1) MOBA_PREFETCH(1);
    bf16x8 qf[2][4];
#pragma unroll
    for (int tb = 0; tb < 2; ++tb) { const bf16_t* qrow = Zn + (size_t)(R0 + wid * 32 + 16 * tb + r) * 3072 + 1024 + h * 128 + q4 * 8;
#pragma unroll
      for (int kk = 0; kk < 4; ++kk) qf[tb][kk] = *(const bf16x8*)(qrow + kk * 32); }
    f32x4 o[2][8];
#pragma unroll
    for (int tb = 0; tb < 2; ++tb)
#pragma unroll
        for (int e = 0; e < 8; ++e) o[tb][e] = (f32x4){0.f, 0.f, 0.f, 0.f};
    float m_run[2] = {-1e30f, -1e30f}, l_run[2] = {0.f, 0.f};
    for (int kt = 0; kt < nkt; ++kt) {
        __syncthreads();
        LAS unsigned char* cb = lds + (kt & 1) * BUF;
        if (kt + 1 < nkt) { LAS unsigned char* nb = lds + ((kt + 1) & 1) * BUF; MOBA_WRITE(nb); if (kt + 2 < nkt) MOBA_PREFETCH(kt + 2); }
        const int nblk = kt >> 2; const bool own = (nblk == qb);
        if (!own || kt * 64 <= t0w + 31) {
            f32x4 sacc[2][4];
#pragma unroll
            for (int tb = 0; tb < 2; ++tb)
#pragma unroll
                for (int sb = 0; sb < 4; ++sb) sacc[tb][sb] = (f32x4){0.f, 0.f, 0.f, 0.f};
#define MOBA_KF(dst, kk_) do { _Pragma("unroll") for (int sb = 0; sb < 4; ++sb) dst[sb] = *(const LAS bf16x8*)(cb + (16 * sb + r) * KST + (kk_) * 64 + q4 * 16); } while (0)
#define MOBA_VF(dst, eb_) do { _Pragma("unroll") for (int e2 = 0; e2 < 2; ++e2) _Pragma("unroll") for (int c = 0; c < 2; ++c) { const LAS unsigned char* vp = cb + OFF_V + (16 * ((eb_) + e2) + r) * VST + (32 * c + 4 * q4) * 2; \
                const s16x4 lo = *(const LAS s16x4*)vp, hi = *(const LAS s16x4*)(vp + 32); dst[e2][c] = __builtin_shufflevector(lo, hi, 0, 1, 2, 3, 4, 5, 6, 7); } } while (0)
            bf16x8 ka[4], kb[4], va[2][2], vb[2][2];
            MOBA_KF(ka, 0);
#pragma unroll
            for (int kk = 0; kk < 4; kk += 2) {
                MOBA_KF(kb, kk + 1); __builtin_amdgcn_sched_barrier(0); __builtin_amdgcn_s_setprio(1);
#pragma unroll
                for (int sb = 0; sb < 4; ++sb) { sacc[0][sb] = MFMA16(ka[sb], qf[0][kk], sacc[0][sb]); sacc[1][sb] = MFMA16(ka[sb], qf[1][kk], sacc[1][sb]); }
                __builtin_amdgcn_s_setprio(0); __builtin_amdgcn_sched_barrier(0);
                if (kk + 2 < 4) MOBA_KF(ka, kk + 2); else MOBA_VF(va, 0);
                __builtin_amdgcn_sched_barrier(0); __builtin_amdgcn_s_setprio(1);
#pragma unroll
                for (int sb = 0; sb < 4; ++sb) { sacc[0][sb] = MFMA16(kb[sb], qf[0][kk + 1], sacc[0][sb]); sacc[1][sb] = MFMA16(kb[sb], qf[1][kk + 1], sacc[1][sb]); }
                __builtin_amdgcn_s_setprio(0); __builtin_amdgcn_sched_barrier(0);
            }
            bf16x8 pf[2][2];
#pragma unroll
            for (int tb = 0; tb < 2; ++tb) {
                const int t0b = t0w + 16 * tb;
                float mx = -1e30f;
                const bool diag = own && (kt * 64 + 63 > t0b);
                bool rowok = true;
                if (diag) { const int dbase = t0b + r - (kt * 64 + 4 * q4);
#pragma unroll
                    for (int sb = 0; sb < 4; ++sb)
#pragma unroll
                        for (int i = 0; i < 4; ++i) { sacc[tb][sb][i] = (dbase - 16 * sb - i >= 0) ? sacc[tb][sb][i] : -1e30f; mx = fmaxf(mx, sacc[tb][sb][i]); }
                } else { rowok = own || (((mysel[tb] >> nblk) & 1u) != 0u);
#pragma unroll
                    for (int sb = 0; sb < 4; ++sb) mx = fmaxf(fmaxf(mx, fmaxf(sacc[tb][sb][0], sacc[tb][sb][1])), fmaxf(sacc[tb][sb][2], sacc[tb][sb][3]));
                    mx = rowok ? mx : -1e30f; }
                mx = fmaxf(mx, __shfl_xor(mx, 16)); mx = fmaxf(mx, __shfl_xor(mx, 32));
                const float m_new = fmaxf(m_run[tb], mx);
                const float alpha = __builtin_amdgcn_exp2f(m_run[tb] - m_new);
                float ps = 0.f;
                if (diag) {
#pragma unroll
                    for (int sb = 0; sb < 4; ++sb)
#pragma unroll
                        for (int i = 0; i < 4; ++i) { const float p = sacc[tb][sb][i] > -1e29f ? __builtin_amdgcn_exp2f(sacc[tb][sb][i] - m_new) : 0.f; sacc[tb][sb][i] = p; ps += p; }
                } else { const float mm = rowok ? m_new : 1e30f;
#pragma unroll
                    for (int sb = 0; sb < 4; ++sb)
#pragma unroll
                        for (int i = 0; i < 4; ++i) { const float p = __builtin_amdgcn_exp2f(sacc[tb][sb][i] - mm); sacc[tb][sb][i] = p; ps += p; } }
                l_run[tb] = l_run[tb] * alpha + ps; m_run[tb] = m_new;
#pragma unroll
                for (int e = 0; e < 8; ++e) o[tb][e] = o[tb][e] * alpha;
#pragma unroll
                for (int c = 0; c < 2; ++c) pf[tb][c] = __builtin_bit_cast(bf16x8, pack8(sacc[tb][2 * c], sacc[tb][2 * c + 1]));
            }
#pragma unroll
            for (int eb = 0; eb < 8; eb += 4) {
                MOBA_VF(vb, eb + 2); __builtin_amdgcn_sched_barrier(0); __builtin_amdgcn_s_setprio(1);
#pragma unroll
                for (int e2 = 0; e2 < 2; ++e2)
#pragma unroll
                    for (int c = 0; c < 2; ++c) { o[0][eb + e2] = MFMA16(va[e2][c], pf[0][c], o[0][eb + e2]); o[1][eb + e2] = MFMA16(va[e2][c], pf[1][c], o[1][eb + e2]); }
                __builtin_amdgcn_s_setprio(0); if (eb + 4 < 8) MOBA_VF(va, eb + 4);
                __builtin_amdgcn_sched_barrier(0); __builtin_amdgcn_s_setprio(1);
#pragma unroll
                for (int e2 = 0; e2 < 2; ++e2)
#pragma unroll
                    for (int c = 0; c < 2; ++c) { o[0][eb + 2 + e2] = MFMA16(vb[e2][c], pf[0][c], o[0][eb + 2 + e2]); o[1][eb + 2 + e2] = MFMA16(vb[e2][c], pf[1][c], o[1][eb + 2 + e2]); }
                __builtin_amdgcn_s_setprio(0); __builtin_amdgcn_sched_barrier(0);
            }
#undef MOBA_KF
#undef MOBA_VF
        }
    }
#undef MOBA_PREFETCH
#undef MOBA_WRITE
#pragma unroll
    for (int tb = 0; tb < 2; ++tb) {
        float l = l_run[tb]; l += __shfl_xor(l, 16); l += __shfl_xor(l, 32);
        const float inv = 1.0f / l;
        const size_t row = (size_t)(R0 + wid * 32 + 16 * tb + r);
#pragma unroll
        for (int eb = 0; eb < 8; ++eb) { const int e = 16 * eb + 4 * q4;
            u32x2 w; w.x = pg8::cvt_pk_bf16(o[tb][eb][0] * inv, o[tb][eb][1] * inv); w.y = pg8::cvt_pk_bf16(o[tb][eb][2] * inv, o[tb][eb][3] * inv);
            *(u32x2*)(Y + row * D + 1024 + h * 128 + e) = w; } }
}

__device__ __forceinline__ void pool_unit(LAS unsigned char* lds, const bf16_t* Zn, bf16_t* Y, const bf16_t* Wt  , const float* scale  , int rt, int gi, int tid, int wid, int lane) {
    asm volatile("" : "+v"(tid), "+v"(lane));
    constexpr int AST = 544;
    const int r = lane & 15, q4 = lane >> 4;
    const int R0 = rt * 128, p0 = R0 & (SEQ - 1), win = 2 << gi;
    __syncthreads();
    { const int cc = tid & 31, tg = tid >> 5;
      const bf16_t* zb = Zn + (size_t)R0 * 3072 + gi * 256 + cc * 8;
      const int tfirst = tg * 8;
      u32x4 zr[23];
#pragma unroll
      for (int k = 0; k < 23; ++k) { int tt = tfirst - 15 + k; tt = (p0 + tt >= 0) ? tt : -p0; zr[k] = *(const u32x4*)(zb + (ptrdiff_t)tt * 3072); }
#pragma unroll
      for (int j8 = 0; j8 < 8; ++j8) { const int pos = p0 + tfirst + j8;
          f32x4 s0 = (f32x4){0.f, 0.f, 0.f, 0.f}, s1 = (f32x4){0.f, 0.f, 0.f, 0.f};
#pragma unroll
          for (int dt = 0; dt < 16; ++dt) { const u32x4 w = zr[15 + j8 - dt]; const float m = (dt < win && pos - dt >= 0) ? 1.f : 0.f;
              s0 += (f32x4){bf_lo(w.x), bf_hi(w.x), bf_lo(w.y), bf_hi(w.y)} * m; s1 += (f32x4){bf_lo(w.z), bf_hi(w.z), bf_lo(w.w), bf_hi(w.w)} * m; }
          const u32x4 w = zr[15 + j8]; const float ic = __builtin_amdgcn_rcpf((float)(pos + 1 < win ? pos + 1 : win));
          const f32x4 a = s0 * ic - (f32x4){bf_lo(w.x), bf_hi(w.x), bf_lo(w.y), bf_hi(w.y)}, bq = s1 * ic - (f32x4){bf_lo(w.z), bf_hi(w.z), bf_lo(w.w), bf_hi(w.w)};
          *(LAS u32x4*)(lds + (tfirst + j8) * AST + cc * 16) = pack8(a, bq); } }
    bf16x8 wf[2][8];
    { const bf16_t* wb = Wt + (size_t)gi * 65536 + (size_t)(32 * wid + r) * 256 + q4 * 8;
#pragma unroll
      for (int nbi = 0; nbi < 2; ++nbi)
#pragma unroll
          for (int kk = 0; kk < 8; ++kk) wf[nbi][kk] = *(const bf16x8*)(wb + (size_t)nbi * 16 * 256 + kk * 32); }
    __syncthreads();
    f32x4 sc[2];
#pragma unroll
    for (int nbi = 0; nbi < 2; ++nbi) sc[nbi] = *(const f32x4*)(scale + gi * 256 + 32 * wid + 16 * nbi + 4 * q4);
#define POOL_AF(dst, tb_) do { _Pragma("unroll") for (int kk = 0; kk < 8; ++kk) dst[kk] = *(const LAS bf16x8*)(lds + (16 * (tb_) + r) * AST + kk * 64 + q4 * 16); } while (0)
    bf16x8 afa[8], afb[8];
    POOL_AF(afa, 0);
#pragma unroll
    for (int tb = 0; tb < 8; ++tb) { f32x4 acc[2] = {(f32x4){0.f, 0.f, 0.f, 0.f}, (f32x4){0.f, 0.f, 0.f, 0.f}};
        if (tb + 1 < 8) { if (tb & 1) POOL_AF(afa, tb + 1); else POOL_AF(afb, tb + 1); }
        __builtin_amdgcn_sched_barrier(0);
#pragma unroll
        for (int kk = 0; kk < 8; ++kk) { const bf16x8 af = (tb & 1) ? afb[kk] : afa[kk];
            acc[0] = MFMA16(wf[0][kk], af, acc[0]); acc[1] = MFMA16(wf[1][kk], af, acc[1]); }
        __builtin_amdgcn_sched_barrier(0);
        const size_t row = (size_t)(R0 + 16 * tb + r);
#pragma unroll
        for (int nbi = 0; nbi < 2; ++nbi) { const int n = 32 * wid + 16 * nbi + 4 * q4;
            u32x2 w; w.x = pg8::cvt_pk_bf16(acc[nbi][0] * sc[nbi][0], acc[nbi][1] * sc[nbi][1]); w.y = pg8::cvt_pk_bf16(acc[nbi][2] * sc[nbi][2], acc[nbi][3] * sc[nbi][3]);
            *(u32x2*)(Y + row * D + gi * 256 + n) = w; } }
#undef POOL_AF
}

constexpr int NPH = 1 + 12 * DEPTH;
struct Args { const float* in[17]; float* out; unsigned char* ws; int ph_lo, ph_hi; };
typedef const __attribute__((address_space(4))) Args* ArgP;
__device__ __forceinline__ ArgP argp() { ArgP p = (ArgP)__builtin_amdgcn_kernarg_segment_ptr(); asm volatile("" : "+s"(p)); return p; }
#define PHASE_LOCALS() ArgP ap = argp(); unsigned char* const ws = ap->ws; int tid = threadIdx.x; asm volatile("" : "+v"(tid)); \
    int G_ = gridDim.x, bx_ = blockIdx.x; asm volatile("" : "+s"(G_), "+s"(bx_)); \
    const int lane = tid & 63, wid = __builtin_amdgcn_readfirstlane(tid >> 6), G = G_, bx = bx_, vcu = (G % 8 == 0) ? (bx % 8) * (G / 8) + bx / 8 : bx, gw = vcu * 8 + wid, NGW = G * 8; \
    (void)lane; (void)gw; (void)NGW; (void)ws
__global__ void __launch_bounds__(512, 2) mega_fwd(Args args_unused) {
    extern __shared__ __attribute__((aligned(16))) unsigned char lds_raw[];
    LAS unsigned char* lds = (LAS unsigned char*)lds_raw;
    volatile LAS unsigned* MISC = (volatile LAS unsigned*)(lds + MISC_OFF);
    for (int u = threadIdx.x; u < (LDS_BYTES - RING_BYTES) / 4; u += 512) ((LAS unsigned*)(lds + RING_BYTES))[u] = 0u;
    __syncthreads();
    int lo, hi; XcdBarrier bar;
    { ArgP ap = argp(); lo = ap->ph_lo; hi = ap->ph_hi; unsigned* ctl = (unsigned*)(ap->ws + WS_CTL);
      bar.bar = ctl + CW_BAR; bar.x = 0; bar.st = nullptr;
      if (hi - lo > 1) bar = xcd_barrier_post(ctl + CW_BAR, MISC + 8); }
#define IN(k) (lo <= (k) && (k) < hi)
#define SEAM(k) do { if (IN(k) && IN((k) + 1)) xcd_barrier(bar); } while (0)
#define P_T   ((bf16_t*)(ws + WS_T))
#define P_Y   ((bf16_t*)(ws + WS_Y))
#define P_BIG ((bf16_t*)(ws + WS_BIG))
#define P_ZT  ((bf16_t*)(ws + WS_BIG + 256 * MiB))
#define P_XB  ((bf16_t*)(ws + WS_H))
#define P_RS  ((float*)(ws + WS_RS))
#define P_X8  ((unsigned char*)(ws + WS_X8))

    if (IN(0)) {
        PHASE_LOCALS();
        LAS float* scr = (LAS float*)(lds + wid * 16384);
        for (int L = 0; L < DEPTH; ++L) {
            const int j = L >> 1;
            for (int f = 0; f < 2; ++f) {
                bf16_t* wgu = (bf16_t*)(ws + WS_WGU + (size_t)(L * 2 + f) * SZ_WGU);
                if (gu_f8(L, f)) { xpose_matrix_f8(ap->in[3] + (size_t)(L * 2 + f) * D * FF, D, FF, (unsigned char*)wgu, F8_WGSCALE, scr, gw, NGW, lane, 1, ap->in[2] + (size_t)(L * 8 + 4 * f) * D);
                                   xpose_matrix_f8(ap->in[4] + (size_t)(L * 2 + f) * D * FF, D, FF, (unsigned char*)wgu, F8_WGSCALE, scr, gw, NGW, lane, 2, ap->in[2] + (size_t)(L * 8 + 4 * f) * D); }
                else { xpose_matrix(ap->in[3] + (size_t)(L * 2 + f) * D * FF, D, FF, wgu, 1, scr, gw, NGW, lane, ap->in[2] + (size_t)(L * 8 + 4 * f) * D);
                       xpose_matrix(ap->in[4] + (size_t)(L * 2 + f) * D * FF, D, FF, wgu, 2, scr, gw, NGW, lane, ap->in[2] + (size_t)(L * 8 + 4 * f) * D); }
                if (dn_f8(L, f)) xpose_matrix_f8(ap->in[5] + (size_t)(L * 2 + f) * FF * D, FF, D, ws + WS_WDN + (size_t)(L * 2 + f) * SZ_WDN, F8_WSCALE, scr, gw, NGW, lane);
                else xpose_matrix(ap->in[5] + (size_t)(L * 2 + f) * FF * D, FF, D, (bf16_t*)(ws + WS_WDN + (size_t)(L * 2 + f) * SZ_WDN), 0, scr, gw, NGW, lane);
            }
            if ((L & 1) == 0) {
                xpose_matrix(ap->in[6] + (size_t)j * D * 6144, D, 6144, (bf16_t*)(ws + WS_WINE + (size_t)j * 6144 * D * 2), 3, scr, gw, NGW, lane, ap->in[2] + (size_t)(L * 8 + 2) * D);
                xpose_matrix(ap->in[7] + (size_t)j * D * D, D, D, (bf16_t*)(ws + WS_WOUT + (size_t)L * D * D * 2), 0, scr, gw, NGW, lane);
            } else {
                xpose_matrix(ap->in[11] + (size_t)j * D * 4096, D, 4096, (bf16_t*)(ws + WS_WINO + (size_t)j * 4096 * D * 2), 0, scr, gw, NGW, lane, ap->in[2] + (size_t)(L * 8 + 2) * D);
                xpose_matrix(ap->in[12] + (size_t)j * D * D, D, D, (bf16_t*)(ws + WS_WOUT + (size_t)L * D * D * 2), 0, scr, gw, NGW, lane);
                for (int g = 0; g < 4; ++g) xpose_matrix(ap->in[13] + (size_t)(j * 4 + g) * 65536, 256, 256, (bf16_t*)(ws + WS_POOLW) + (size_t)(j * 4 + g) * 65536, 0, scr, gw, NGW, lane);
            }
            xpose_matrix(ap->in[15] + (size_t)L * D * D, D, D, (bf16_t*)(ws + WS_WPG + (size_t)L * D * D * 2), 0, scr, gw, NGW, lane, ap->in[2] + (size_t)(L * 8 + 6) * D);
            xpose_matrix(ap->in[16] + (size_t)L * PLE * D, PLE, D, (bf16_t*)(ws + WS_WPP + (size_t)L * D * PLE * 2), 0, scr, gw, NGW, lane);
        }
        { const float* p_in = ap->in[1]; bf16_t* pb = (bf16_t*)(ws + WS_PBF); const size_t n8 = (size_t)DEPTH * M * PLE / 8;
          for (size_t i = (size_t)gw * 64 + lane; i < n8; i += (size_t)NGW * 64) { const f32x4 a = *(const f32x4*)(p_in + i * 8), b2 = *(const f32x4*)(p_in + i * 8 + 4); *(u32x4*)(pb + i * 8) = pack8(a, b2); } }
        { float* rc = (float*)(ws + WS_RCOS); float* rs = (float*)(ws + WS_RSIN); float* mc = (float*)(ws + WS_MCOS); float* ms = (float*)(ws + WS_MSIN);
          const int gt = gw * 64 + lane, NT = NGW * 64;
          for (int i = gt; i < SEQ * 128; i += NT) { const int t = i >> 7, f = i & 127; const float inv = 1.0f / powf(10000.0f, (float)f / 128.0f); const float ang = (float)t * inv;
              double rv = (double)ang * 0.15915494309189535; rv -= __builtin_rint(rv); rc[i] = __builtin_amdgcn_cosf((float)rv); rs[i] = __builtin_amdgcn_sinf((float)rv); }
          for (int i = gt; i < SEQ * 16; i += NT) { const int t = i >> 4, f = i & 15; const float inv = 1.0f / powf(500000.0f, (float)f / 16.0f); const float ang = (float)t * inv;
              double rv = (double)ang * 0.15915494309189535; rv -= __builtin_rint(rv); mc[i] = __builtin_amdgcn_cosf((float)rv); ms[i] = __builtin_amdgcn_sinf((float)rv); }
          const float* sgw = ap->in[8]; bf16_t* sw = (bf16_t*)(ws + WS_SGUW);
          for (int i = gt; i < 2 * 4 * 128 * 128; i += NT) { const int s = i & 127, t = (i >> 7) & 127; sw[i] = (bf16_t)f2bf(s <= t ? sgw[i] : 0.f); } }
        rphase<false, true, false>(ap->in[0], P_XB, nullptr, 0.f, nullptr, P_RS, gw, NGW, lane, gu_f8(0, 0) ? P_X8 : nullptr);
    }
    SEAM(0);

    for (int L = 0; L < DEPTH; ++L) {
        const int pb = 1 + 12 * L;
        if (IN(pb + 0)) { PHASE_LOCALS(); pg8::Gemm g{P_XB, (const bf16_t*)(ws + WS_WGU + (size_t)(L * 2) * SZ_WGU), M, 2 * FF, D}; pg8::StaticOrder S; S.init(M, 2 * FF, G, bx); if (gu_f8(L, 0)) { pg8::Gemm g8{(const bf16_t*)P_X8, g.Bt, M, 2 * FF, D / 2}; EpiGU8 E{(unsigned char*)P_BIG, P_RS, 1.f / (F8_XSCALE * F8_WGSCALE)}; pg8::gemm_phase<EpiGU8, pg8::StaticOrder, true, true, true>(lds, g8, S, E); }
            else if (dn_f8(L, 0)) { EpiGU8 E{(unsigned char*)P_BIG, P_RS, 1.f}; pg8::gemm_phase<EpiGU8, pg8::StaticOrder, true, true>(lds, g, S, E); }
            else { EpiGU E{P_BIG, P_RS}; pg8::gemm_phase<EpiGU, pg8::StaticOrder, true, true>(lds, g, S, E); } }
        SEAM(pb + 0);
        if (IN(pb + 1)) { PHASE_LOCALS(); pg8::StaticOrder S; S.init(M, D, G, bx);
            if (dn_f8(L, 0)) { pg8::Gemm g{P_BIG, (const bf16_t*)(ws + WS_WDN + (size_t)(L * 2) * SZ_WDN), M, D, FF / 2}; EpiPlainS E{P_T, D, 1.f / (F8_ASCALE * F8_WSCALE)};
                pg8::gemm_phase<EpiPlainS, pg8::StaticOrder, true, true, true>(lds, g, S, E); }
            else { pg8::Gemm g{P_BIG, (const bf16_t*)(ws + WS_WDN + (size_t)(L * 2) * SZ_WDN), M, D, FF}; EpiPlain E{P_T, D, 1 << 30};
                pg8::gemm_phase<EpiPlain, pg8::StaticOrder, true, true>(lds, g, S, E); } }
        SEAM(pb + 1);
        if (IN(pb + 2)) { PHASE_LOCALS(); const float* ng = ap->in[2] + (size_t)L * 8 * D; rphase<true, false, false>(P_XB, P_XB, P_T, 0.5f, ng + 1 * D, P_RS, gw, NGW, lane); }
        SEAM(pb + 2);
        if (IN(pb + 3)) {
            PHASE_LOCALS(); const int j = L >> 1;
            if ((L & 1) == 0) { const bf16_t* Win = (const bf16_t*)(ws + WS_WINE + (size_t)j * 6144 * D * 2);
                { pg8::Gemm g{P_XB, Win, M, 4096, D}; pg8::StaticOrder S; S.init(M, 4096, G, bx); EpiInEven E{P_BIG, (const float*)(ws + WS_RCOS), (const float*)(ws + WS_RSIN), P_RS};
                  pg8::gemm_phase<EpiInEven, pg8::StaticOrder, true, true>(lds, g, S, E); }
                { pg8::Gemm g{Win + (size_t)4096 * D, P_XB, 2048, M, D}; pg8::StaticOrder S; S.init(2048, M, G, bx); EpiPlainT E{P_ZT, M, 4, P_RS};
                  pg8::gemm_phase<EpiPlainT, pg8::StaticOrder, true, true>(lds, g, S, E); }
            } else { const bf16_t* Win = (const bf16_t*)(ws + WS_WINO + (size_t)j * 4096 * D * 2);
                { pg8::Gemm g{P_XB, Win, M, 3072, D}; pg8::StaticOrder S; S.init(M, 3072, G, bx); EpiInOdd E{P_BIG, (const float*)(ws + WS_MCOS), (const float*)(ws + WS_MSIN), (float*)(ws + WS_KSUM) + (size_t)j * 128 * 1024, P_RS};
                  pg8::gemm_phase<EpiInOdd, pg8::StaticOrder, true, true>(lds, g, S, E); }
                { pg8::Gemm g{Win + (size_t)3072 * D, P_XB, 1024, M, D}; pg8::StaticOrder S; S.init(1024, M, G, bx); EpiPlainT E{P_ZT, M, 1 << 30, P_RS};
                  pg8::gemm_phase<EpiPlainT, pg8::StaticOrder, true, true>(lds, g, S, E); }
            }
        }
        SEAM(pb + 3);
        if (IN(pb + 4)) {
            PHASE_LOCALS(); const int j = L >> 1;
            if ((L & 1) == 0) {
                const bf16_t* sw = (const bf16_t*)(ws + WS_SGUW) + (size_t)j * 4 * 16384;
                for (int u = bx; u < 512 + 1024; u += G) {
                    if (u < 512) { const int uix = ((u >> 3) & 31) + 32 * (u >> 8), bh = 8 * (u & 7) + (uix >> 3), pr = uix & 7;
                        ret_tile(lds, P_BIG, P_ZT, P_Y, bh >> 2, bh & 3, 15 - pr, tid, wid, lane);
                        ret_tile(lds, P_BIG, P_ZT, P_Y, bh >> 2, bh & 3, pr, tid, wid, lane);
                    } else { const int v = u - 512; sgu_unit(lds, P_BIG, P_ZT, P_Y, sw, ap->in[9] + (size_t)j * 512, ap->in[10] + (size_t)j * 1024, v >> 6, (v >> 2) & 15, v & 3, tid, wid, lane); }
                }
            } else {
                const float* ks = (const float*)(ws + WS_KSUM) + (size_t)j * 128 * 1024;
                const bf16_t* pw = (const bf16_t*)(ws + WS_POOLW) + (size_t)j * 4 * 65536;
                for (int u = bx; u < 512 + 1024; u += G) {
                    if (u < 512) { const int uix = ((u >> 3) & 31) + 32 * (u >> 8), bh = 16 * (u & 7) + (uix >> 2), pr = uix & 3;
                        moba_tile(lds, P_BIG, P_ZT, P_Y, ks, bh >> 3, bh & 7, 7 - pr, tid, wid, lane);
                        moba_tile(lds, P_BIG, P_ZT, P_Y, ks, bh >> 3, bh & 7, pr, tid, wid, lane);
                    } else { const int v = u - 512; pool_unit(lds, P_BIG, P_Y, pw, ap->in[14] + (size_t)j * 1024, v >> 2, v & 3, tid, wid, lane); }
                }
            }
        }
        SEAM(pb + 4);
        if (IN(pb + 5)) { PHASE_LOCALS(); pg8::Gemm g{P_Y, (const bf16_t*)(ws + WS_WOUT + (size_t)L * D * D * 2), M, D, D}; pg8::StaticOrder S; S.init(M, D, G, bx); EpiPlain E{P_T, D, 1 << 30};
            pg8::gemm_phase<EpiPlain, pg8::StaticOrder, true, true>(lds, g, S, E); }
        SEAM(pb + 5);
        if (IN(pb + 6)) { PHASE_LOCALS(); const float* ng = ap->in[2] + (size_t)L * 8 * D; rphase<true, false, false>(P_XB, P_XB, P_T, 1.0f, ng + 3 * D, P_RS, gw, NGW, lane, gu_f8(L, 1) ? P_X8 : nullptr); }
        SEAM(pb + 6);
        if (IN(pb + 7)) { PHASE_LOCALS(); pg8::Gemm g{P_XB, (const bf16_t*)(ws + WS_WGU + (size_t)(L * 2 + 1) * SZ_WGU), M, 2 * FF, D}; pg8::StaticOrder S; S.init(M, 2 * FF, G, bx); if (gu_f8(L, 1)) { pg8::Gemm g8{(const bf16_t*)P_X8, g.Bt, M, 2 * FF, D / 2}; EpiGU8 E{(unsigned char*)P_BIG, P_RS, 1.f / (F8_XSCALE * F8_WGSCALE)}; pg8::gemm_phase<EpiGU8, pg8::StaticOrder, true, true, true>(lds, g8, S, E); }
            else if (dn_f8(L, 1)) { EpiGU8 E{(unsigned char*)P_BIG, P_RS, 1.f}; pg8::gemm_phase<EpiGU8, pg8::StaticOrder, true, true>(lds, g, S, E); }
            else { EpiGU E{P_BIG, P_RS}; pg8::gemm_phase<EpiGU, pg8::StaticOrder, true, true>(lds, g, S, E); } }
        SEAM(pb + 7);
        if (IN(pb + 8)) {
            PHASE_LOCALS();
            if (dn_f8(L, 1)) { pg8::Gemm g{P_BIG, (const bf16_t*)(ws + WS_WDN + (size_t)(L * 2 + 1) * SZ_WDN), M, D, FF / 2}; pg8::StaticOrder S; S.init(M, D, G, bx); EpiPlainS E{P_T, D, 1.f / (F8_ASCALE * F8_WSCALE)};
              pg8::gemm_phase<EpiPlainS, pg8::StaticOrder, true, true, true>(lds, g, S, E); }
            else { pg8::Gemm g{P_BIG, (const bf16_t*)(ws + WS_WDN + (size_t)(L * 2 + 1) * SZ_WDN), M, D, FF}; pg8::StaticOrder S; S.init(M, D, G, bx); EpiPlain E{P_T, D, 1 << 30};
              pg8::gemm_phase<EpiPlain, pg8::StaticOrder, true, true>(lds, g, S, E); }
            { pg8::Gemm g{(const bf16_t*)(ws + WS_PBF) + (size_t)L * M * PLE, (const bf16_t*)(ws + WS_WPP + (size_t)L * D * PLE * 2), M, D, PLE}; pg8::StaticOrder S; S.init(M, D, G, bx); EpiPlain E{P_Y, D, 1 << 30};
              pg8::gemm_phase<EpiPlain, pg8::StaticOrder, true, true>(lds, g, S, E); }
        }
        SEAM(pb + 8);
        if (IN(pb + 9)) { PHASE_LOCALS(); const float* ng = ap->in[2] + (size_t)L * 8 * D; rphase<true, false, false>(P_XB, P_XB, P_T, 0.5f, ng + 5 * D, P_RS, gw, NGW, lane); }
        SEAM(pb + 9);
        if (IN(pb + 10)) { PHASE_LOCALS(); pg8::Gemm g{P_XB, (const bf16_t*)(ws + WS_WPG + (size_t)L * D * D * 2), M, D, D}; pg8::StaticOrder S; S.init(M, D, G, bx); EpiPleGate E{P_T, P_Y, P_RS};
            pg8::gemm_phase<EpiPleGate, pg8::StaticOrder, true, true>(lds, g, S, E); }
        SEAM(pb + 10);
        if (IN(pb + 11)) { PHASE_LOCALS(); const float* ng = ap->in[2] + (size_t)L * 8 * D; if (L + 1 < DEPTH) rphase<true, false, false>(P_XB, P_XB, P_T, 1.0f, ng + 7 * D, P_RS, gw, NGW, lane, gu_f8(L + 1, 0) ? P_X8 : nullptr);
            else rphase<true, false, true>(P_XB, ap->out, P_T, 1.0f, ng + 7 * D, nullptr, gw, NGW, lane); }
        SEAM(pb + 11);
    }
#undef IN
#undef SEAM
}

#ifndef MK_MULTI
#define MK_MULTI 0
#endif
extern "C" void kernel_launch(void* const* d_in, const int* in_sizes, int n_in, void* d_out, int out_size, void* d_ws, size_t ws_size, hipStream_t stream) {
    static int grid = 0;
    if (grid == 0) {
        if (n_in != 17 || in_sizes[0] != M * D || out_size != M * D || ws_size < WS_END) { fprintf(stderr, "kernel_launch: unexpected shapes (n_in %d, in0 %d, out %d, ws %zu < %zu)\n", n_in, n_in > 0 ? in_sizes[0] : -1, out_size, ws_size, (size_t)WS_END); grid = -1; return; }
        int dev = 0, cus = 0, per_cu = 0;
        if (hipGetDevice(&dev) != hipSuccess || hipDeviceGetAttribute(&cus, hipDeviceAttributeMultiprocessorCount, dev) != hipSuccess) { grid = -1; return; }
        if (hipFuncSetAttribute((const void*)mega_fwd, hipFuncAttributeMaxDynamicSharedMemorySize, LDS_BYTES) != hipSuccess) { fprintf(stderr, "kernel_launch: hipFuncSetAttribute failed\n"); grid = -1; return; }
        if (hipOccupancyMaxActiveBlocksPerMultiprocessor(&per_cu, (const void*)mega_fwd, 512, LDS_BYTES) != hipSuccess || per_cu < 1) { fprintf(stderr, "kernel_launch: occupancy query reports %d\n", per_cu); }
        (void)hipGetLastError();
        grid = cus;
    }
    if (grid < 0) return;
    (void)hipMemsetAsync((char*)d_ws + WS_CTL, 0, CTL_ZERO_BYTES, stream);
    Args a{};
    for (int i = 0; i < 17; ++i) a.in[i] = (const float*)d_in[i];
    a.out = (float*)d_out; a.ws = (unsigned char*)d_ws;
#if MK_MULTI
    for (int p = 0; p < NPH; ++p) { a.ph_lo = p; a.ph_hi = p + 1; hipLaunchKernelGGL(mega_fwd, dim3(grid), dim3(512), LDS_BYTES, stream, a); }
#else
    a.ph_lo = 0; a.ph_hi = NPH;
    hipLaunchKernelGGL(mega_fwd, dim3(grid), dim3(512), LDS_BYTES, stream, a);
#endif
    const hipError_t le = hipPeekAtLastError();
    if (le != hipSuccess) fprintf(stderr, "kernel_launch: launch failed: %s\n", hipGetErrorName(le));
}
```
